# Optimizing an MI355X kernel written in HIP

```python
import jax, jax.numpy as jnp
from jax import lax
import numpy as np

D_MODEL = 2048
BATCH = 1
SEQ = 8192
DEPTH = 2
DEC_BATCH = 2
DEC_SEQ = 16384
PAST_LEN = 128

N_MIXERS = 2
EXPAND = 2
E_WIDTH = EXPAND * D_MODEL
GRID_W = 64
CHUNK = 128
A_GROUPS = 16
A_GROUP_DIM = E_WIDTH // A_GROUPS
B_HEADS = 32
B_HEAD_DIM = E_WIDTH // B_HEADS
NA_ROWS = 8
NA_COLS = 16
N_A_LAYERS = (DEPTH + 1) // 2
N_B_LAYERS = DEPTH // 2
EPS = 1e-6

kernel_name = "hybrid_gmlp_natten_encoder"


def rmsnorm(x, g):
    xf = x.astype(jnp.float32)
    inv = lax.rsqrt(jnp.mean(xf * xf, axis=-1, keepdims=True) + EPS)
    return (xf * inv).astype(x.dtype) * g


def gmlp_mixer(h, w_in, v_g, w_s, b_s, w_out):
    bsz, t, _ = h.shape
    proj = h @ w_in
    u, v, z = jnp.split(proj, 3, axis=-1)
    u = jax.nn.gelu(u)
    v = rmsnorm(jax.nn.gelu(v), v_g)
    v = v.reshape(bsz, t // CHUNK, CHUNK, A_GROUPS, A_GROUP_DIM)
    s = jnp.einsum('gpq,bnqgc->bnpgc', w_s, v) + b_s.T[None, None, :, :, None]
    s = s.reshape(bsz, t, E_WIDTH)
    y = u * s * jax.nn.silu(z)
    return y @ w_out


def na_mixer(h, w_in, rpb, w_out):
    bsz, t, _ = h.shape
    rows = t // GRID_W
    kh = min(NA_ROWS, rows)
    kw = NA_COLS
    proj = h @ w_in
    q, k, v, z = jnp.split(proj, 4, axis=-1)
    shp = (bsz, rows, GRID_W, B_HEADS, B_HEAD_DIM)
    q = q.reshape(shp) * (B_HEAD_DIM ** -0.5)
    k = k.reshape(shp)
    v = v.reshape(shp)
    col = jnp.arange(GRID_W)
    col_start = jnp.clip(col - kw // 2, 0, GRID_W - kw)
    col_idx = col_start[:, None] + jnp.arange(kw)[None, :]
    col_off = col_idx - col[:, None] + (NA_COLS - 1)

    def row_block(r):
        r0 = jnp.clip(r - kh // 2, 0, rows - kh)
        k_rows = lax.dynamic_slice_in_dim(k, r0, kh, axis=1)
        v_rows = lax.dynamic_slice_in_dim(v, r0, kh, axis=1)
        k_win = k_rows[:, :, col_idx]
        v_win = v_rows[:, :, col_idx]
        q_r = lax.dynamic_index_in_dim(q, r, axis=1, keepdims=False)
        sc = jnp.einsum('bchd,bicjhd->bhcij', q_r, k_win).astype(jnp.float32)
        row_off = r0 + jnp.arange(kh) - r + (NA_ROWS - 1)
        bias = rpb[:, row_off[None, :, None], col_off[:, None, :]]
        sc = sc + bias[None].astype(jnp.float32)
        p = jax.nn.softmax(sc.reshape(bsz, B_HEADS, GRID_W, kh * kw), axis=-1)
        p = p.reshape(bsz, B_HEADS, GRID_W, kh, kw).astype(v.dtype)
        return jnp.einsum('bhcij,bicjhd->bchd', p, v_win)

    out = lax.map(row_block, jnp.arange(rows))
    out = jnp.moveaxis(out, 0, 1).reshape(bsz, t, E_WIDTH)
    y = out * jax.nn.silu(z)
    return y @ w_out


def trunk(x, norm_g, final_g, a_w_in, a_v_g, a_ws, a_bs, a_w_out, b_w_in, b_rpb, b_w_out):
    for i in range(DEPTH):
        h = rmsnorm(x, norm_g[i])
        j = i // N_MIXERS
        if i % N_MIXERS == 0:
            y = gmlp_mixer(h, a_w_in[j], a_v_g[j], a_ws[j], a_bs[j], a_w_out[j])
        else:
            y = na_mixer(h, b_w_in[j], b_rpb[j], b_w_out[j])
        x = x + y
    return rmsnorm(x, final_g)


def setup_inputs(seed: int = 0) -> dict:
    key = jax.random.key(seed)
    ks = jax.random.split(key, 12)
    f32 = jnp.float32
    x_prompt = jax.random.normal(ks[0], (BATCH, SEQ, D_MODEL), f32)
    x_sample = jax.random.normal(ks[1], (DEC_BATCH, DEC_SEQ, D_MODEL), f32)
    norm_g = 1.0 + 0.02 * jax.random.normal(ks[2], (DEPTH, D_MODEL), f32)
    final_g = 1.0 + 0.02 * jax.random.normal(ks[3], (D_MODEL,), f32)
    a_w_in = jax.random.normal(ks[4], (N_A_LAYERS, D_MODEL, 3 * E_WIDTH), f32) * D_MODEL ** -0.5
    a_v_g = 1.0 + 0.02 * jax.random.normal(ks[5], (N_A_LAYERS, E_WIDTH), f32)
    a_ws = jax.random.normal(ks[6], (N_A_LAYERS, A_GROUPS, CHUNK, CHUNK), f32) * CHUNK ** -0.5
    a_bs = 1.0 + 0.02 * jax.random.normal(ks[7], (N_A_LAYERS, A_GROUPS, CHUNK), f32)
    a_w_out = jax.random.normal(ks[8], (N_A_LAYERS, E_WIDTH, D_MODEL), f32) * E_WIDTH ** -0.5
    b_w_in = jax.random.normal(ks[9], (N_B_LAYERS, D_MODEL, 4 * E_WIDTH), f32) * D_MODEL ** -0.5
    b_rpb = 0.02 * jax.random.normal(ks[10], (N_B_LAYERS, B_HEADS, 2 * NA_ROWS - 1, 2 * NA_COLS - 1), f32)
    b_w_out = jax.random.normal(ks[11], (N_B_LAYERS, E_WIDTH, D_MODEL), f32) * E_WIDTH ** -0.5
    return {"x_prompt": x_prompt, "x_sample": x_sample, "norm_g": norm_g, "final_g": final_g,
            "a_w_in": a_w_in, "a_v_g": a_v_g, "a_ws": a_ws, "a_bs": a_bs, "a_w_out": a_w_out,
            "b_w_in": b_w_in, "b_rpb": b_rpb, "b_w_out": b_w_out}


def reference(x_prompt, x_sample, norm_g, final_g, a_w_in, a_v_g, a_ws, a_bs, a_w_out, b_w_in, b_rpb, b_w_out):
    y_prompt = trunk(x_prompt, norm_g, final_g, a_w_in, a_v_g, a_ws, a_bs, a_w_out, b_w_in, b_rpb, b_w_out)
    y_sample = trunk(x_sample, norm_g, final_g, a_w_in, a_v_g, a_ws, a_bs, a_w_out, b_w_in, b_rpb, b_w_out)
    return (y_prompt, y_sample)
```

```cpp
#include <hip/hip_runtime.h>
#include <cstdio>
#include <cstdint>
namespace pg8 {
#define PG8_LAS __attribute__((address_space(3)))
typedef unsigned short bf16_t;
typedef short bf16x8 __attribute__((ext_vector_type(8)));
typedef float f32x4 __attribute__((ext_vector_type(4)));
typedef unsigned u32x4 __attribute__((ext_vector_type(4)));
constexpr int BM = 256, BK = 64, HALF = 128, HTB = HALF * BK * 2  , STAGE_BYTES = 8 * HTB, NXCD = 8, WGM = 8;

__host__ __device__ __forceinline__ int lds_byte(int r, int c) { const int st = (r >> 4) * 2 + (c >> 5), rr = r & 15, cc = c & 31, ob = rr * 64 + cc * 2; return st * 1024 + (ob ^ (((ob >> 9) & 1) << 5)); }
__host__ __device__ __forceinline__ void stage_rc(int b, int& R, int& C) { const int st = b / 1024, sb = b % 1024, swz = sb ^ (((sb >> 9) & 1) << 5); R = (st >> 1) * 16 + swz / 64; C = (st & 1) * 32 + (swz % 64) / 2; }
__host__ __device__ __forceinline__ int perm32(int rho) { const int n = rho >> 4, i = rho & 15; return 8 * (i >> 2) + 4 * n + (i & 3); }

struct Unit { int pm, pn; };
struct Gemm { const bf16_t* A; const bf16_t* Bt; int M, N, K; };

struct StaticOrder {
    int nM, nN, nwg, G, c;
    __host__ __device__ void init(int M, int N, int G_, int c_) { nM = M / BM; nN = N / BM; nwg = nM * nN; G = G_; c = c_; }
    __host__ __device__ bool next(int i, Unit& u) const {
        const long L = (long)i * G + c; if (L >= nwg) return false;
        int wgid = (int)L; { const int q = nwg / NXCD, r = nwg % NXCD, xcd = wgid % NXCD, off = wgid / NXCD; wgid = (xcd < r ? xcd * (q + 1) : r * (q + 1) + (xcd - r) * q) + off; }
        const int nig = WGM * nN, gid = wgid / nig, fm = gid * WGM, gsz = (nM - fm) < WGM ? (nM - fm) : WGM;
        u.pm = fm + ((wgid % nig) % gsz); u.pn = (wgid % nig) / gsz; return true;
    }
    __device__ __forceinline__ void a_ready(const Unit&) const {}
    __device__ __forceinline__ void done(const Unit&) const {}
};

__device__ __forceinline__ unsigned cvt_pk_bf16(float lo, float hi) { unsigned r; asm volatile("v_cvt_pk_bf16_f32 %0, %1, %2" : "=v"(r) : "v"(lo), "v"(hi)); return r; }
typedef float f32x2 __attribute__((ext_vector_type(2)));
__device__ __forceinline__ float gelu_tanh(float x) { const float t = x * (1.0f + 0.044715f * x * x); return x * __builtin_amdgcn_rcpf(1.0f + __builtin_amdgcn_exp2f(-2.3022081981f * t)); }
__device__ __forceinline__ float silu_f(float x) { return x * __builtin_amdgcn_rcpf(1.0f + __builtin_amdgcn_exp2f(-1.4426950409f * x)); }

struct EpiAin {
    static constexpr bool PERM = true, AFTER_DRAIN = false;
    bf16_t* O; float* stats;
    __device__ __forceinline__ void operator()(const f32x4 (&acc)[2][2][4][2], const Unit& u, int wr, int wc, int fr, int fq) const {
        const int reg = u.pn >> 4;
        const int row0 = u.pm * BM + wr * 64 + fr, col0 = u.pn * BM + wc * 32 + 8 * fq;
#pragma unroll
        for (int ai = 0; ai < 2; ++ai)
#pragma unroll
            for (int m = 0; m < 4; ++m) {
                const int row = row0 + ai * HALF + m * 16;
                bf16_t* rowp = O + (size_t)row * 12288 + col0;
                float ss = 0.f;
#pragma unroll
                for (int bj = 0; bj < 2; ++bj) {
                    f32x4 v0 = acc[ai][bj][m][0], v1 = acc[ai][bj][m][1];
                    if (reg == 2) {
#pragma unroll
                        for (int e = 0; e < 4; ++e) { v0[e] = silu_f(v0[e]); v1[e] = silu_f(v1[e]); }
                    } else {
#pragma unroll
                        for (int e = 0; e < 4; ++e) { v0[e] = gelu_tanh(v0[e]); v1[e] = gelu_tanh(v1[e]); }
                    }
                    if (reg == 1) ss += (v0[0] * v0[0] + v0[1] * v0[1]) + (v0[2] * v0[2] + v0[3] * v0[3]) + (v1[0] * v1[0] + v1[1] * v1[1]) + (v1[2] * v1[2] + v1[3] * v1[3]);
                    u32x4 w; w.x = cvt_pk_bf16(v0[0], v0[1]); w.y = cvt_pk_bf16(v0[2], v0[3]); w.z = cvt_pk_bf16(v1[0], v1[1]); w.w = cvt_pk_bf16(v1[2], v1[3]);
                    *(u32x4*)(rowp + bj * HALF) = w;
                }
                if (reg == 1) { ss += __shfl_xor(ss, 16); ss += __shfl_xor(ss, 32); if (fq == 0) stats[(size_t)row * 64 + (u.pn - 16) * 4 + wc] = ss; }
            }
    }
};
struct EpiBin {
    static constexpr bool PERM = true, AFTER_DRAIN = false;
    bf16_t* O;
    __device__ __forceinline__ void operator()(const f32x4 (&acc)[2][2][4][2], const Unit& u, int wr, int wc, int fr, int fq) const {
        const int reg = u.pn >> 4;
        const int row0 = u.pm * BM + wr * 64 + fr, col0 = u.pn * BM + wc * 32 + 8 * fq;
#pragma unroll
        for (int ai = 0; ai < 2; ++ai)
#pragma unroll
            for (int m = 0; m < 4; ++m) {
                bf16_t* rowp = O + (size_t)(row0 + ai * HALF + m * 16) * 16384 + col0;
#pragma unroll
                for (int bj = 0; bj < 2; ++bj) {
                    f32x4 v0 = acc[ai][bj][m][0], v1 = acc[ai][bj][m][1];
                    if (reg == 0) { v0 = v0 * 0.08838834764831845f; v1 = v1 * 0.08838834764831845f; }
                    if (reg == 3) {
#pragma unroll
                        for (int e = 0; e < 4; ++e) { v0[e] = silu_f(v0[e]); v1[e] = silu_f(v1[e]); }
                    }
                    u32x4 w; w.x = cvt_pk_bf16(v0[0], v0[1]); w.y = cvt_pk_bf16(v0[2], v0[3]); w.z = cvt_pk_bf16(v1[0], v1[1]); w.w = cvt_pk_bf16(v1[2], v1[3]);
                    *(u32x4*)(rowp + bj * HALF) = w;
                }
            }
    }
};
struct EpiRes {
    static constexpr bool PERM = false, AFTER_DRAIN = false;
    const float* base; float* out;
    __device__ __forceinline__ void operator()(const f32x4 (&acc)[2][2][4][2], const Unit& u, int wr, int wc, int fr, int fq) const {
        const int row0 = u.pm * BM + wr * 64 + fr, col0 = u.pn * BM + wc * 32 + 4 * fq;
#pragma unroll
        for (int ai = 0; ai < 2; ++ai)
#pragma unroll
            for (int m = 0; m < 4; ++m) {
                const size_t off = (size_t)(row0 + ai * HALF + m * 16) * 2048 + col0;
#pragma unroll
                for (int bj = 0; bj < 2; ++bj)
#pragma unroll
                    for (int n = 0; n < 2; ++n) { const f32x4 b = *(const f32x4*)(base + off + bj * HALF + n * 16); *(f32x4*)(out + off + bj * HALF + n * 16) = b + acc[ai][bj][m][n]; }
            }
    }
};

template <class Epi, class Sched, bool ALIGN_EPI = false, bool SP2 = false>
__device__ __forceinline__ void gemm_phase(PG8_LAS unsigned char* lds, const Gemm g, const Sched& S, const Epi& E) {
    const int tid = threadIdx.x, wid = __builtin_amdgcn_readfirstlane(tid >> 6), lane = tid & 63, wr = wid >> 2, wc = wid & 3, fr = lane & 15, fq = lane >> 4;
    const int K = g.K, nt = K / BK;
    unsigned voffA[2], voffB[2];
#pragma unroll
    for (int i = 0; i < 2; ++i) { int R, C; stage_rc(tid * 16 + i * 8192, R, C); const int Rb = Epi::PERM ? ((R & ~31) + perm32(R & 31)) : R;
        voffA[i] = (unsigned)(R * K + C) * 2u; voffB[i] = (unsigned)(Rb * K + C) * 2u; }
    const size_t kstep = (size_t)(BK * 2);
    const size_t hstep = (size_t)HALF * K * 2;
    const size_t tstep = 2 * hstep;
    const unsigned ldsw = (unsigned)wid * 1024u;
    const int aoff = lds_byte(wr * 64 + fr, fq * 8), boff = lds_byte(wc * 32 + fr, fq * 8);
#define PG8_SA(b, h) (((b) * 2 + (h)) * HTB)
#define PG8_SB(b, h) ((4 + (b) * 2 + (h)) * HTB)
#define PG8_STAGE(bufoff, gbase, voff) do { _Pragma("unroll") for (int _i = 0; _i < 2; ++_i) \
        __builtin_amdgcn_global_load_lds((const unsigned*)((const char*)(gbase) + (voff)[_i]), (PG8_LAS unsigned*)(lds + (bufoff) + ldsw + _i * 8192), 16, 0, 0); } while (0)
#define PG8_LDA(dst, b, h) do { _Pragma("unroll") for (int m = 0; m < 4; ++m) _Pragma("unroll") for (int k = 0; k < 2; ++k) dst[m][k] = *(const PG8_LAS bf16x8*)(lds + PG8_SA(b, h) + aoff + m * 2048 + k * 1024); } while (0)
#define PG8_LDB(dst, b, h) do { _Pragma("unroll") for (int n = 0; n < 2; ++n) _Pragma("unroll") for (int k = 0; k < 2; ++k) dst[n][k] = *(const PG8_LAS bf16x8*)(lds + PG8_SB(b, h) + boff + n * 2048 + k * 1024); } while (0)
#define PG8_MMA(ai, bj, At, Bt) do { __builtin_amdgcn_s_setprio(1); _Pragma("unroll") for (int m = 0; m < 4; ++m) _Pragma("unroll") for (int n = 0; n < 2; ++n) _Pragma("unroll") for (int k = 0; k < 2; ++k) \
        acc[ai][bj][m][n] = __builtin_amdgcn_mfma_f32_16x16x32_bf16(Bt[n][k], At[m][k], acc[ai][bj][m][n], 0, 0, 0); __builtin_amdgcn_s_setprio(0); } while (0)
#define PG8_WAIT_V(n) asm volatile("s_waitcnt vmcnt(" #n ")" ::: "memory")
#define PG8_WAIT_L(n) asm volatile("s_waitcnt lgkmcnt(" #n ")" ::: "memory")
#define PG8_BAR __builtin_amdgcn_s_barrier()
#define PG8_SCHED __builtin_amdgcn_sched_barrier(0)
    Unit cur, nxt; int ui = 0;
    if (!S.next(0, cur)) return;
    f32x4 acc[2][2][4][2];
#pragma unroll
    for (int a = 0; a < 2; ++a)
#pragma unroll
        for (int b = 0; b < 2; ++b)
#pragma unroll
            for (int m = 0; m < 4; ++m)
#pragma unroll
                for (int n = 0; n < 2; ++n) acc[a][b][m][n] = (f32x4){0.f, 0.f, 0.f, 0.f};
    bf16x8 At[4][2], B0[2][2], B1[2][2];
    const char* cA = (const char*)g.A + (size_t)cur.pm * tstep; const char* cB = (const char*)g.Bt + (size_t)cur.pn * tstep;
    S.a_ready(cur);
    if constexpr (SP2) {
        PG8_STAGE(PG8_SB(0, 0), cB, voffB); PG8_STAGE(PG8_SB(0, 1), cB + hstep, voffB); PG8_STAGE(PG8_SA(0, 0), cA, voffA); PG8_STAGE(PG8_SA(0, 1), cA + hstep, voffA);
        if (wr == 1) PG8_BAR;
        PG8_WAIT_V(2); PG8_BAR;
        PG8_STAGE(PG8_SB(1, 0), cB + kstep, voffB); PG8_STAGE(PG8_SA(1, 0), cA + kstep, voffA); PG8_STAGE(PG8_SB(1, 1), cB + hstep + kstep, voffB);
        PG8_WAIT_V(6); PG8_BAR;
    } else {
        PG8_STAGE(PG8_SB(0, 0), cB, voffB); PG8_STAGE(PG8_SA(0, 0), cA, voffA); PG8_STAGE(PG8_SB(0, 1), cB + hstep, voffB); PG8_STAGE(PG8_SA(0, 1), cA + hstep, voffA);
        if (wr == 1) PG8_BAR;
        PG8_WAIT_V(4); PG8_BAR;
        PG8_STAGE(PG8_SB(1, 0), cB + kstep, voffB); PG8_STAGE(PG8_SA(1, 0), cA + kstep, voffA); PG8_STAGE(PG8_SB(1, 1), cB + hstep + kstep, voffB);
        PG8_WAIT_V(6); PG8_BAR;
    }
    for (;;) {
        const bool has_next = S.next(ui + 1, nxt);
        const char* nA = has_next ? (const char*)g.A + (size_t)nxt.pm * tstep : cA; const char* nB = has_next ? (const char*)g.Bt + (size_t)nxt.pn * tstep : cB;
        for (int t = 0; t < nt; t += 2) {
            const bool last = (t == nt - 2);
            const char* a1 = cA + (size_t)(t + 1) * kstep;
            const char* a2 = last ? nA : cA + (size_t)(t + 2) * kstep; const char* b2 = last ? nB : cB + (size_t)(t + 2) * kstep;
            const char* a3 = a2 + kstep; const char* b3 = b2 + kstep;
            if (last && has_next) S.a_ready(nxt);
            if constexpr (SP2) {
            PG8_LDB(B0, 0, 0); PG8_LDB(B1, 0, 1); PG8_SCHED; PG8_LDA(At, 0, 0); PG8_STAGE(PG8_SA(1, 1), a1 + hstep, voffA);
            PG8_WAIT_V(8); PG8_WAIT_L(0); PG8_BAR; PG8_MMA(0, 0, At, B0); PG8_MMA(0, 1, At, B1); PG8_BAR; PG8_SCHED;
            PG8_LDA(At, 0, 1); PG8_STAGE(PG8_SB(0, 0), b2, voffB); PG8_STAGE(PG8_SB(0, 1), b2 + hstep, voffB); PG8_STAGE(PG8_SA(0, 0), a2, voffA);
            PG8_WAIT_V(8); PG8_WAIT_L(0); PG8_BAR; PG8_MMA(1, 0, At, B0); PG8_MMA(1, 1, At, B1); PG8_BAR; PG8_SCHED;
            PG8_LDB(B0, 1, 0); PG8_LDB(B1, 1, 1); PG8_SCHED; PG8_LDA(At, 1, 0); PG8_STAGE(PG8_SA(0, 1), a2 + hstep, voffA);
            PG8_WAIT_V(8); PG8_WAIT_L(0); PG8_BAR; PG8_MMA(0, 0, At, B0); PG8_MMA(0, 1, At, B1); PG8_BAR; PG8_SCHED;
            PG8_LDA(At, 1, 1); PG8_STAGE(PG8_SB(1, 0), b3, voffB); PG8_STAGE(PG8_SB(1, 1), b3 + hstep, voffB); PG8_STAGE(PG8_SA(1, 0), a3, voffA);
            PG8_WAIT_V(8); PG8_WAIT_L(0); PG8_BAR; PG8_MMA(1, 0, At, B0); PG8_MMA(1, 1, At, B1); PG8_BAR; PG8_SCHED;
            } else {
            PG8_LDB(B0, 0, 0); PG8_SCHED; PG8_LDA(At, 0, 0); PG8_STAGE(PG8_SA(1, 1), a1 + hstep, voffA);
            PG8_WAIT_L(8); PG8_BAR; PG8_WAIT_L(0); PG8_MMA(0, 0, At, B0); PG8_BAR; PG8_SCHED;
            PG8_LDB(B1, 0, 1); PG8_STAGE(PG8_SB(0, 0), b2, voffB);
            PG8_BAR; PG8_WAIT_L(0); PG8_MMA(0, 1, At, B1); PG8_BAR;
            PG8_LDA(At, 0, 1); PG8_STAGE(PG8_SA(0, 0), a2, voffA);
            PG8_BAR; PG8_WAIT_L(0); PG8_MMA(1, 0, At, B0); PG8_BAR; PG8_SCHED;
            PG8_STAGE(PG8_SB(0, 1), b2 + hstep, voffB);
            PG8_WAIT_V(6); PG8_BAR; PG8_MMA(1, 1, At, B1); PG8_BAR;
            PG8_LDB(B0, 1, 0); PG8_SCHED; PG8_LDA(At, 1, 0); PG8_STAGE(PG8_SA(0, 1), a2 + hstep, voffA);
            PG8_WAIT_L(8); PG8_BAR; PG8_WAIT_L(0); PG8_MMA(0, 0, At, B0); PG8_BAR; PG8_SCHED;
            PG8_LDB(B1, 1, 1); PG8_STAGE(PG8_SB(1, 0), b3, voffB);
            PG8_BAR; PG8_WAIT_L(0); PG8_MMA(0, 1, At, B1); PG8_BAR;
            PG8_LDA(At, 1, 1); PG8_STAGE(PG8_SA(1, 0), a3, voffA);
            PG8_BAR; PG8_WAIT_L(0); PG8_MMA(1, 0, At, B0); PG8_BAR; PG8_SCHED;
            PG8_STAGE(PG8_SB(1, 1), b3 + hstep, voffB);
            PG8_WAIT_V(6); PG8_BAR; PG8_MMA(1, 1, At, B1); PG8_BAR;
            }
        }
        if constexpr (ALIGN_EPI) { if (wr == 0) PG8_BAR; }
        if constexpr (!Epi::AFTER_DRAIN) { E(acc, cur, wr, wc, fr, fq); S.done(cur); }
        if (!has_next) break;
#pragma unroll
        for (int a = 0; a < 2; ++a)
#pragma unroll
            for (int b = 0; b < 2; ++b)
#pragma unroll
                for (int m = 0; m < 4; ++m)
#pragma unroll
                    for (int n = 0; n < 2; ++n) acc[a][b][m][n] = (f32x4){0.f, 0.f, 0.f, 0.f};
        cur = nxt; cA = nA; cB = nB; ++ui;
        if constexpr (ALIGN_EPI) { if (wr == 1) PG8_BAR; }
    }
    PG8_WAIT_V(0);
    if constexpr (!ALIGN_EPI) { if (wr == 0) PG8_BAR; }
    PG8_BAR;
    if constexpr (Epi::AFTER_DRAIN) { E.fused(acc, cur, wr, wc, fr, fq, lds, wid, lane); S.done(cur); }
#undef PG8_SA
#undef PG8_SB
#undef PG8_STAGE
#undef PG8_LDA
#undef PG8_LDB
#undef PG8_MMA
#undef PG8_WAIT_V
#undef PG8_WAIT_L
#undef PG8_BAR
#undef PG8_SCHED
}
}
#define GAS __attribute__((address_space(1)))
#define LAS __attribute__((address_space(3)))
typedef unsigned short bf16;
typedef unsigned v4u __attribute__((ext_vector_type(4)));
typedef float f32x4 __attribute__((ext_vector_type(4)));
typedef short bf16x8 __attribute__((ext_vector_type(8)));
typedef GAS unsigned gu32;
typedef GAS unsigned long long gu64;
#define RLX_AGENT __ATOMIC_RELAXED, __HIP_MEMORY_SCOPE_AGENT
#define LDS_WAIT() asm volatile("s_waitcnt lgkmcnt(0)" ::: "memory")
#define VM_WAIT() asm volatile("s_waitcnt vmcnt(0)" ::: "memory")
__device__ __forceinline__ unsigned long long rt() { return __builtin_amdgcn_s_memrealtime(); }
__device__ __forceinline__ unsigned f2bf(float f) { unsigned u = __builtin_bit_cast(unsigned, f); return (u + 0x7fffu + ((u >> 16) & 1u)) >> 16; }
__device__ __forceinline__ unsigned pk2(float lo, float hi) { return f2bf(lo) | (f2bf(hi) << 16); }
#define XB_TMO      128
#define XB_XCNT(j)  (256  + 64 * (j))
#define XB_XSUB(j)  (1280 + 64 * (j))
#define XB_XGEN(j)  (2304 + 64 * (j))
#define XB_TOP      3328
#define XB_TOPGEN   3392
#define XCD_BAR_WORDS 3456
#define XB_SPIN_CAP (1u << 18)

__device__ __forceinline__ unsigned xb_ld(unsigned* p)              { return __hip_atomic_load(p, __ATOMIC_RELAXED, __HIP_MEMORY_SCOPE_AGENT); }
__device__ __forceinline__ unsigned xb_add(unsigned* p, unsigned v) { return __hip_atomic_fetch_add(p, v, __ATOMIC_RELAXED, __HIP_MEMORY_SCOPE_AGENT); }
__device__ __forceinline__ unsigned xb_xcc_id() { return (unsigned)__builtin_amdgcn_s_getreg((3 << 11) | 20) & 0xFu; }
#define XB_SPIN(cond, bar) do { unsigned _sp = 0; while (cond) { __builtin_amdgcn_s_sleep(1); \
    if ((++_sp & 255u) == 0u) { if (xb_ld(&(bar)[XB_TMO])) break; if (_sp > XB_SPIN_CAP) { atomicAdd(&(bar)[XB_TMO], 1u); break; } } } } while (0)

struct XcdBarrier {
    unsigned* bar; unsigned x;
    volatile LAS unsigned* st;
};

__device__ __forceinline__ XcdBarrier xcd_barrier_post(unsigned* bar, volatile LAS unsigned* st) {
    XcdBarrier b; b.bar = bar; b.x = xb_xcc_id(); b.st = st;
    if (threadIdx.x == 0) (void)xb_add(&bar[XB_XCNT(b.x)], 1u);
    return b;
}
__device__ __forceinline__ void xcd_barrier_complete(unsigned* bar, unsigned x, unsigned& nloc, unsigned& nx) {
    const unsigned G = gridDim.x * gridDim.y * gridDim.z;
    unsigned sum, cnt, mine, sp = 0u;
    for (;;) {
        sum = 0u; cnt = 0u; mine = 0u;
#pragma unroll
        for (unsigned j = 0; j < 16; ++j) { const unsigned c = xb_ld(&bar[XB_XCNT(j)]); sum += c; cnt += (c > 0u) ? 1u : 0u; mine = (j == x) ? c : mine; }
        if (sum == G) break;
        __builtin_amdgcn_s_sleep(1);
        if ((++sp & 255u) == 0u) { if (xb_ld(&bar[XB_TMO])) break; if (sp > XB_SPIN_CAP) { atomicAdd(&bar[XB_TMO], 1u); break; } }
    }
    nloc = mine > 0u ? mine : 1u; nx = cnt > 0u ? cnt : 1u;
}

__device__ __forceinline__ void xcd_barrier(const XcdBarrier& b) {
    asm volatile("s_waitcnt vmcnt(0)" ::: "memory");
    __syncthreads();
    if (threadIdx.x == 0) {
        unsigned* bar = b.bar;
        __builtin_amdgcn_s_waitcnt(0);
        unsigned nloc = b.st[0], nx = b.st[1];
        if (nloc == 0u) { xcd_barrier_complete(bar, b.x, nloc, nx); b.st[0] = nloc; b.st[1] = nx; }
        const unsigned old = xb_add(&bar[XB_XSUB(b.x)], 1u);
        const unsigned gen = old / nloc;
        if (old + 1u == (gen + 1u) * nloc) {
            __builtin_amdgcn_fence(__ATOMIC_RELEASE, "agent");
            asm volatile("s_waitcnt vmcnt(0)" ::: "memory");
            const unsigned og = xb_add(&bar[XB_TOP], 1u);
            const unsigned tg = og / nx;
            if (og + 1u == (tg + 1u) * nx) xb_add(&bar[XB_TOPGEN], 1u);
            else XB_SPIN(xb_ld(&bar[XB_TOPGEN]) == tg, bar);
            __builtin_amdgcn_fence(__ATOMIC_ACQUIRE, "agent");
            xb_add(&bar[XB_XGEN(b.x)], 1u);
            asm volatile("s_waitcnt vmcnt(0)" ::: "memory");
        } else {
            XB_SPIN(xb_ld(&bar[XB_XGEN(b.x)]) == gen, bar);
            __builtin_amdgcn_fence(__ATOMIC_ACQUIRE, "agent");
            asm volatile("s_waitcnt vmcnt(0)" ::: "memory");
        }
    }
    __syncthreads();
}
__device__ __forceinline__ float wave_sum(float v) {
#pragma unroll
    for (int o = 1; o < 64; o <<= 1) v += __shfl_xor(v, o);
    return v;
}
__device__ __forceinline__ void p0_transpose_item(const float* W, int K, int N, bf16* WT, int row_off, LAS float* scr, int item, int lane) {
    const int nblk = N / 32, kb = item / nblk, nb = item % nblk, k0 = 64 * kb, n0 = 32 * nb;
#pragma unroll 8
    for (int i = 0; i < 32; ++i) { const int kk = 2 * i + (lane >> 5); scr[kk * 33 + (lane & 31)] = W[(size_t)(k0 + kk) * N + n0 + (lane & 31)]; }
    LDS_WAIT(); asm volatile("" ::: "memory");
    const int c = lane & 7;
#pragma unroll
    for (int j = 0; j < 4; ++j) { const int n = (lane >> 3) + 8 * j; const LAS float* s = scr + (8 * c) * 33 + n;
        v4u o; o.x = pk2(s[0 * 33], s[1 * 33]); o.y = pk2(s[2 * 33], s[3 * 33]); o.z = pk2(s[4 * 33], s[5 * 33]); o.w = pk2(s[6 * 33], s[7 * 33]);
        *(GAS v4u*)(WT + (size_t)(row_off + n0 + n) * K + k0 + 8 * c) = o; }
    LDS_WAIT(); asm volatile("" ::: "memory");
}

constexpr int NWAVES = 8;
constexpr int D = 2048, E = 4096, NA = 3 * E, NB = 4 * E, TP = 8192, TS = 16384, NTOK = TP + 2 * TS, MC = 16384;
constexpr int GRIDW = 64, NHEAD = 32, HD = 128;
constexpr float EPS = 1e-6f;
constexpr size_t MiB = 1u << 20;
constexpr size_t WS_CTL = 0, CTL_ZERO_BYTES = 65536;
constexpr size_t WS_WAIN = 1 * MiB;
constexpr size_t WS_WAOUT = 49 * MiB;
constexpr size_t WS_WBIN = 65 * MiB;
constexpr size_t WS_WBOUT = 129 * MiB;
constexpr size_t WS_XN = 145 * MiB;
constexpr size_t WS_STATS = 209 * MiB;
constexpr size_t WS_Y = 213 * MiB;
constexpr size_t WS_PROJ = 341 * MiB;
constexpr size_t WS_END = 853 * MiB;
constexpr int CW_BAR = 4096;
static_assert((CW_BAR + XCD_BAR_WORDS) * 4 <= (int)CTL_ZERO_BYTES, "CTL words inside the memset region");
constexpr int RING_BYTES = 131072;
constexpr int LDSCTL_OFF = RING_BYTES, MISC_OFF = LDSCTL_OFF + 320;
constexpr int LDS_BYTES = 147456;
static_assert(MISC_OFF + 128 <= LDS_BYTES, "LDS map");

__device__ __forceinline__ float bf2f(unsigned short b) { return __builtin_bit_cast(float, (unsigned)b << 16); }
__device__ __forceinline__ float bflo(unsigned w) { return __builtin_bit_cast(float, w << 16); }
__device__ __forceinline__ float bfhi(unsigned w) { return __builtin_bit_cast(float, w & 0xffff0000u); }
typedef __bf16 bf16x2_t __attribute__((ext_vector_type(2)));
__device__ __forceinline__ float dot2bf(unsigned a, unsigned b, float acc) { return __builtin_amdgcn_fdot2_f32_bf16(__builtin_bit_cast(bf16x2_t, a), __builtin_bit_cast(bf16x2_t, b), acc, false); }

__device__ __forceinline__ void rms_row_to_bf16(const float* xrow, const float* g, bf16* orow, int lane) {
    const f32x4* xr = (const f32x4*)xrow + lane; const f32x4* gr = (const f32x4*)g + lane;
    f32x4 v[8]; float s = 0.f;
#pragma unroll
    for (int j = 0; j < 8; ++j) { v[j] = xr[64 * j]; s += (v[j].x * v[j].x + v[j].y * v[j].y) + (v[j].z * v[j].z + v[j].w * v[j].w); }
    const float inv = 1.0f / sqrtf(wave_sum(s) * (1.f / D) + EPS);
    unsigned long long* o8 = (unsigned long long*)orow + lane;
#pragma unroll
    for (int j = 0; j < 8; ++j) { const f32x4 gg = gr[64 * j]; const f32x4 o = (v[j] * inv) * gg;
        o8[64 * j] = (unsigned long long)pk2(o.x, o.y) | ((unsigned long long)pk2(o.z, o.w) << 32); }
}
__device__ __forceinline__ void rms_row_inplace(float* xrow, const float* g, int lane) {
    f32x4* xr = (f32x4*)xrow + lane; const f32x4* gr = (const f32x4*)g + lane;
    f32x4 v[8]; float s = 0.f;
#pragma unroll
    for (int j = 0; j < 8; ++j) { v[j] = xr[64 * j]; s += (v[j].x * v[j].x + v[j].y * v[j].y) + (v[j].z * v[j].z + v[j].w * v[j].w); }
    const float inv = 1.0f / sqrtf(wave_sum(s) * (1.f / D) + EPS);
#pragma unroll
    for (int j = 0; j < 8; ++j) { const f32x4 gg = gr[64 * j]; xr[64 * j] = (v[j] * inv) * gg; }
}

struct Args { const float* in[12]; float* out; unsigned char* ws; };

__global__ void __launch_bounds__(NWAVES * 64, 2) fwd(Args args) {
    extern __shared__ __attribute__((aligned(16))) unsigned char lds_raw[];
    LAS unsigned char* lds = (LAS unsigned char*)lds_raw;
    volatile LAS unsigned* MISC = (volatile LAS unsigned*)(lds + MISC_OFF);
    const int tid = threadIdx.x, lane0 = tid & 63, wave = __builtin_amdgcn_readfirstlane(tid >> 6);
    const int G = gridDim.x; const int bx = blockIdx.x; const int vcu = (G % 8 == 0) ? (bx % 8) * (G / 8) + bx / 8 : bx;
    const int gw = vcu * NWAVES + wave, NGW = G * NWAVES;
#define FRESH_S(x) asm volatile("" : "+s"(x))
#define FRESH_V(x) asm volatile("" : "+v"(x))
#define PHASE_PTRS() size_t z_ = 0; FRESH_S(z_); unsigned char* ws = args.ws + z_; int lane = lane0; FRESH_V(lane); \
    bf16* WAIN = (bf16*)(ws + WS_WAIN); bf16* WAOUT = (bf16*)(ws + WS_WAOUT); bf16* WBIN = (bf16*)(ws + WS_WBIN); bf16* WBOUT = (bf16*)(ws + WS_WBOUT); \
    bf16* XN = (bf16*)(ws + WS_XN); float* STATS = (float*)(ws + WS_STATS); bf16* Y = (bf16*)(ws + WS_Y); bf16* PROJ = (bf16*)(ws + WS_PROJ); \
    (void)WAIN; (void)WAOUT; (void)WBIN; (void)WBOUT; (void)XN; (void)STATS; (void)Y; (void)PROJ; (void)lane
#define GRID_BAR() do { XcdBarrier b_ = bar; size_t zb_ = 0; FRESH_S(zb_); b_.bar = bar.bar + zb_; xcd_barrier(b_); } while (0)
    for (int u = tid; u < (LDS_BYTES - LDSCTL_OFF) / 4; u += NWAVES * 64) ((LAS unsigned*)(lds + LDSCTL_OFF))[u] = 0u;
    __syncthreads();
    XcdBarrier bar = xcd_barrier_post((unsigned*)(args.ws + WS_CTL) + CW_BAR, MISC + 8);

#ifndef SKIP_P0
    {
        PHASE_PTRS();
        LAS float* scr = (LAS float*)(lds + wave * 16384);
        constexpr int I_AIN = (D / 64) * (NA / 32), I_AOUT = (E / 64) * (D / 32), I_BIN = (D / 64) * (NB / 32), I_BOUT = (E / 64) * (D / 32);
        constexpr int NITEMS = I_AIN + I_AOUT + I_BIN + I_BOUT;
        for (int it = gw; it < NITEMS; it += NGW) {
            int r = it;
            if (r < I_AIN) { p0_transpose_item(args.in[4], D, NA, WAIN, 0, scr, r, lane); continue; } r -= I_AIN;
            if (r < I_AOUT) { p0_transpose_item(args.in[8], E, D, WAOUT, 0, scr, r, lane); continue; } r -= I_AOUT;
            if (r < I_BIN) { p0_transpose_item(args.in[9], D, NB, WBIN, 0, scr, r, lane); continue; } r -= I_BIN;
            p0_transpose_item(args.in[11], E, D, WBOUT, 0, scr, r, lane);
        }
    }
#endif
    GRID_BAR();

    for (int sc = 0; sc < 3; ++sc) {
        const int M = (sc == 0) ? TP : TS;
        const int r0 = (sc == 0) ? 0 : TP + (sc - 1) * TS;
        const float* xin = (sc == 0) ? args.in[0] : args.in[1] + (size_t)(sc - 1) * TS * D;
        float* xo = args.out + (size_t)r0 * D;

        { PHASE_PTRS(); for (int row = gw; row < M; row += NGW) rms_row_to_bf16(xin + (size_t)row * D, args.in[2], XN + (size_t)row * D, lane); }
        GRID_BAR();

        {
            PHASE_PTRS();
            pg8::Gemm g{XN, WAIN, M, NA, D}; pg8::StaticOrder S; S.init(M, NA, G, bx);
            pg8::EpiAin Ep{PROJ, STATS};
            pg8::gemm_phase<pg8::EpiAin, pg8::StaticOrder, true, true>(lds, g, S, Ep);
        }
        GRID_BAR();

#ifndef SKIP_A3
        {
            PHASE_PTRS();
            const int grp = bx & 15;
            LAS float* WT = (LAS float*)lds;
            LAS float* invb = (LAS float*)(lds + 65536 + wave * 512);
            for (int e = tid; e < 16384; e += NWAVES * 64) { const int p = e >> 7, q = e & 127; WT[q * 128 + p] = args.in[6][(size_t)grp * 16384 + e]; }
            __syncthreads();
            const int wslot = (bx >> 4) * NWAVES + wave, nslots = (G >> 4) * NWAVES;
            const int nunits = (M / 128) * 4;
            for (int wu = wslot; wu < nunits; wu += nslots) {
                const int chunk = wu >> 2, quarter = wu & 3, rowbase = chunk * 128, c = grp * 256 + quarter * 64 + lane;
#pragma unroll
                for (int rr = 0; rr < 2; ++rr) {
                    const f32x4* sp = (const f32x4*)(STATS + (size_t)(rowbase + lane + 64 * rr) * 64); float s = 0.f;
#pragma unroll
                    for (int k = 0; k < 16; ++k) { const f32x4 t = sp[k]; s += (t.x + t.y) + (t.z + t.w); }
                    invb[lane + 64 * rr] = 1.0f / sqrtf(s * (1.f / E) + EPS);
                }
                LDS_WAIT();
                float acc[128];
#pragma unroll
                for (int p = 0; p < 128; ++p) acc[p] = 0.f;
                const bf16* vp = PROJ + (size_t)rowbase * NA + E + c;
                for (int q = 0; q < 128; ++q) {
                    const float v = bf2f(vp[(size_t)q * NA]) * invb[q];
                    const LAS f32x4* w4 = (const LAS f32x4*)(WT + q * 128);
#pragma unroll
                    for (int p4 = 0; p4 < 32; ++p4) { const f32x4 w = w4[p4]; acc[4 * p4 + 0] += w.x * v; acc[4 * p4 + 1] += w.y * v; acc[4 * p4 + 2] += w.z * v; acc[4 * p4 + 3] += w.w * v; }
                }
                const float vg = args.in[5][c];
#pragma unroll
                for (int p = 0; p < 128; ++p) {
                    const size_t ro = (size_t)(rowbase + p) * NA;
                    const float s = acc[p] * vg + args.in[7][grp * 128 + p];
                    const float y = bf2f(PROJ[ro + c]) * s * bf2f(PROJ[ro + 2 * E + c]);
                    Y[(size_t)(rowbase + p) * E + c] = (bf16)f2bf(y);
                }
                LDS_WAIT();
            }
        }
#endif
        GRID_BAR();

        {
            PHASE_PTRS();
            pg8::Gemm g{Y, WAOUT, M, D, E}; pg8::StaticOrder S; S.init(M, D, G, bx);
            pg8::EpiRes Ep{xin, xo};
            pg8::gemm_phase<pg8::EpiRes, pg8::StaticOrder, true, true>(lds, g, S, Ep);
        }
        GRID_BAR();

        { PHASE_PTRS(); for (int row = gw; row < M; row += NGW) rms_row_to_bf16(xo + (size_t)row * D, args.in[2] + D, XN + (size_t)row * D, lane); }
        GRID_BAR();

        {
            PHASE_PTRS();
            pg8::Gemm g{XN, WBIN, M, NB, D}; pg8::StaticOrder S; S.init(M, NB, G, bx);
            pg8::EpiBin Ep{PROJ};
            pg8::gemm_phase<pg8::EpiBin, pg8::StaticOrder, true, true>(lds, g, S, Ep);
        }
        GRID_BAR();

#ifndef SKIP_B3
        {
            PHASE_PTRS();
            const int R = M / GRIDW, nunits = R * NHEAD * 4;
            const int qi = lane >> 2, dsl = lane & 3;
            for (int u = gw; u < nunits; u += NGW) {
                const int qb = u & 3, h = (u >> 2) & 31, r = u >> 7;
                const int c = qb * 16 + qi;
                const int cs = min(max(c - 8, 0), GRIDW - 16), rs = min(max(r - 4, 0), R - 8);
                const size_t qrow = (size_t)(r * GRIDW + c);
                const v4u* qp = (const v4u*)(PROJ + qrow * NB + h * HD + dsl * 32);
                v4u q4[4];
#pragma unroll
                for (int k = 0; k < 4; ++k) q4[k] = qp[k];
                const float* bias_h = args.in[10] + (size_t)h * 15 * 31;
                float mx = -3.0e38f;
                for (int i = 0; i < 8; ++i) {
                    const int kr = rs + i; const float* brow = bias_h + (kr - r + 7) * 31 + (cs - c + 15);
                    for (int j = 0; j < 16; ++j) {
                        const v4u* kp = (const v4u*)(PROJ + (size_t)(kr * GRIDW + cs + j) * NB + E + h * HD + dsl * 32);
                        float s = 0.f;
#pragma unroll
                        for (int k = 0; k < 4; ++k) { const v4u kk = kp[k]; s = dot2bf(q4[k].x, kk.x, s); s = dot2bf(q4[k].y, kk.y, s); s = dot2bf(q4[k].z, kk.z, s); s = dot2bf(q4[k].w, kk.w, s); }
                        s += __shfl_xor(s, 1); s += __shfl_xor(s, 2);
                        s += brow[j];
                        mx = fmaxf(mx, s);
                    }
                }
                float l = 0.f; float o[32];
#pragma unroll
                for (int d = 0; d < 32; ++d) o[d] = 0.f;
                for (int i = 0; i < 8; ++i) {
                    const int kr = rs + i; const float* brow = bias_h + (kr - r + 7) * 31 + (cs - c + 15);
                    for (int j = 0; j < 16; ++j) {
                        const size_t krow = (size_t)(kr * GRIDW + cs + j);
                        const v4u* kp = (const v4u*)(PROJ + krow * NB + E + h * HD + dsl * 32);
                        const v4u* vp = (const v4u*)(PROJ + krow * NB + 2 * E + h * HD + dsl * 32);
                        float s = 0.f;
#pragma unroll
                        for (int k = 0; k < 4; ++k) { const v4u kk = kp[k]; s = dot2bf(q4[k].x, kk.x, s); s = dot2bf(q4[k].y, kk.y, s); s = dot2bf(q4[k].z, kk.z, s); s = dot2bf(q4[k].w, kk.w, s); }
                        s += __shfl_xor(s, 1); s += __shfl_xor(s, 2);
                        s += brow[j];
                        const float p = __expf(s - mx);
                        l += p;
#pragma unroll
                        for (int k = 0; k < 4; ++k) { const v4u vv = vp[k];
                            o[8 * k + 0] += p * bflo(vv.x); o[8 * k + 1] += p * bfhi(vv.x); o[8 * k + 2] += p * bflo(vv.y); o[8 * k + 3] += p * bfhi(vv.y);
                            o[8 * k + 4] += p * bflo(vv.z); o[8 * k + 5] += p * bfhi(vv.z); o[8 * k + 6] += p * bflo(vv.w); o[8 * k + 7] += p * bfhi(vv.w); }
                    }
                }
                const float il = 1.0f / l;
                const v4u* zp = (const v4u*)(PROJ + qrow * NB + 3 * E + h * HD + dsl * 32);
                v4u* yp = (v4u*)(Y + qrow * E + h * HD + dsl * 32);
#pragma unroll
                for (int k = 0; k < 4; ++k) { const v4u zz = zp[k]; v4u w;
                    w.x = pk2(o[8 * k + 0] * il * bflo(zz.x), o[8 * k + 1] * il * bfhi(zz.x)); w.y = pk2(o[8 * k + 2] * il * bflo(zz.y), o[8 * k + 3] * il * bfhi(zz.y));
                    w.z = pk2(o[8 * k + 4] * il * bflo(zz.z), o[8 * k + 5] * il * bfhi(zz.z)); w.w = pk2(o[8 * k + 6] * il * bflo(zz.w), o[8 * k + 7] * il * bfhi(zz.w));
                    yp[k] = w; }
            }
        }
#endif
        GRID_BAR();

        {
            PHASE_PTRS();
            pg8::Gemm g{Y, WBOUT, M, D, E}; pg8::StaticOrder S; S.init(M, D, G, bx);
            pg8::EpiRes Ep{xo, xo};
            pg8::gemm_phase<pg8::EpiRes, pg8::StaticOrder, true, true>(lds, g, S, Ep);
        }
        GRID_BAR();

        { PHASE_PTRS(); for (int row = gw; row < M; row += NGW) rms_row_inplace(xo + (size_t)row * D, args.in[3], lane); }
    }
}

extern "C" void kernel_launch(void* const* d_in, const int* in_sizes, int n_in, void* d_out, int out_size, void* d_ws, size_t ws_size, hipStream_t stream) {
    static int grid = 0;
    if (grid == 0) {
        if (n_in != 12 || out_size != NTOK * D || ws_size < WS_END) { fprintf(stderr, "kernel_launch: unexpected shapes: n_in %d out %d ws %zu (need %zu)\n", n_in, out_size, ws_size, (size_t)WS_END); grid = -1; return; }
        int dev = 0, cus = 0, per_cu = 0;
        if (hipGetDevice(&dev) != hipSuccess || hipDeviceGetAttribute(&cus, hipDeviceAttributeMultiprocessorCount, dev) != hipSuccess) { grid = -1; return; }
        if (hipFuncSetAttribute((const void*)fwd, hipFuncAttributeMaxDynamicSharedMemorySize, LDS_BYTES) != hipSuccess) { fprintf(stderr, "kernel_launch: hipFuncSetAttribute failed\n"); grid = -1; return; }
        if (hipOccupancyMaxActiveBlocksPerMultiprocessor(&per_cu, (const void*)fwd, NWAVES * 64, LDS_BYTES) != hipSuccess || per_cu < 1)
            fprintf(stderr, "kernel_launch: note: occupancy query reports %d workgroups per CU\n", per_cu);
        (void)hipGetLastError();
        grid = cus;
    }
    if (grid < 0) return;
    if (hipMemsetAsync((char*)d_ws + WS_CTL, 0, CTL_ZERO_BYTES, stream) != hipSuccess) { fprintf(stderr, "kernel_launch: hipMemsetAsync failed\n"); return; }
    Args a{};
    for (int i = 0; i < 12; ++i) a.in[i] = (const float*)d_in[i];
    a.out = (float*)d_out; a.ws = (unsigned char*)d_ws;
    hipLaunchKernelGGL(fwd, dim3(grid), dim3(NWAVES * 64), LDS_BYTES, stream, a);
    const hipError_t le = hipPeekAtLastError();
    if (le != hipSuccess) fprintf(stderr, "kernel_launch: launch failed: %s\n", hipGetErrorName(le));
}
```

```cpp
#include <hip/hip_runtime.h>
#include <cstdio>
#include <cstdint>
template <int MASK> __device__ __forceinline__ float shx(float v) {
    static_assert(MASK < 32, "use add_x32 / max_x32 across the halves");
    return __builtin_bit_cast(float, __builtin_amdgcn_ds_swizzle(__builtin_bit_cast(int, v), (MASK << 10) | 0x1f));
}
__device__ __forceinline__ float add_x32(float v) { const unsigned u = __builtin_bit_cast(unsigned, v); auto r = __builtin_amdgcn_permlane32_swap(u, u, false, false); unsigned a = r[0], b = r[1]; asm volatile("" : "+v"(a), "+v"(b)); return __builtin_bit_cast(float, a) + __builtin_bit_cast(float, b); }
__device__ __forceinline__ float max_x32(float v) { const unsigned u = __builtin_bit_cast(unsigned, v); auto r = __builtin_amdgcn_permlane32_swap(u, u, false, false); unsigned a = r[0], b = r[1]; asm volatile("" : "+v"(a), "+v"(b)); return fmaxf(__builtin_bit_cast(float, a), __builtin_bit_cast(float, b)); }
namespace pg8 {
#define PG8_LAS __attribute__((address_space(3)))
typedef unsigned short bf16_t;
typedef short bf16x8 __attribute__((ext_vector_type(8)));
typedef float f32x4 __attribute__((ext_vector_type(4)));
typedef unsigned u32x4 __attribute__((ext_vector_type(4)));
constexpr int BM = 256, BK = 64, HALF = 128, HTB = HALF * BK * 2  , STAGE_BYTES = 8 * HTB, NXCD = 8, WGM = 8;

__host__ __device__ __forceinline__ int lds_byte(int r, int c) { const int st = (r >> 4) * 2 + (c >> 5), rr = r & 15, cc = c & 31, ob = rr * 64 + cc * 2; return st * 1024 + (ob ^ (((ob >> 9) & 1) << 5)); }
__host__ __device__ __forceinline__ void stage_rc(int b, int& R, int& C) { const int st = b / 1024, sb = b % 1024, swz = sb ^ (((sb >> 9) & 1) << 5); R = (st >> 1) * 16 + swz / 64; C = (st & 1) * 32 + (swz % 64) / 2; }
__host__ __device__ __forceinline__ int perm32(int rho) { const int n = rho >> 4, i = rho & 15; return 8 * (i >> 2) + 4 * n + (i & 3); }

struct Unit { int pm, pn; };
struct Gemm { const bf16_t* A; const bf16_t* Bt; int M, N, K; };

struct StaticOrder {
    int nM, nN, nwg, G, c;
    __host__ __device__ void init(int M, int N, int G_, int c_) { nM = M / BM; nN = N / BM; nwg = nM * nN; G = G_; c = c_; }
    __host__ __device__ bool next(int i, Unit& u) const {
        const long L = (long)i * G + c; if (L >= nwg) return false;
        int wgid = (int)L; { const int q = nwg / NXCD, r = nwg % NXCD, xcd = wgid % NXCD, off = wgid / NXCD; wgid = (xcd < r ? xcd * (q + 1) : r * (q + 1) + (xcd - r) * q) + off; }
        const int nig = WGM * nN, gid = wgid / nig, fm = gid * WGM, gsz = (nM - fm) < WGM ? (nM - fm) : WGM;
        u.pm = fm + ((wgid % nig) % gsz); u.pn = (wgid % nig) / gsz; return true;
    }
    __device__ __forceinline__ void a_ready(const Unit&) const {}
    __device__ __forceinline__ void done(const Unit&) const {}
};

__device__ __forceinline__ unsigned cvt_pk_bf16(float lo, float hi) { unsigned r; asm volatile("v_cvt_pk_bf16_f32 %0, %1, %2" : "=v"(r) : "v"(lo), "v"(hi)); return r; }
typedef float f32x2 __attribute__((ext_vector_type(2)));
__device__ __forceinline__ float gelu_tanh(float x) { const float t = x * (1.0f + 0.044715f * x * x); return x * __builtin_amdgcn_rcpf(1.0f + __builtin_amdgcn_exp2f(-2.3022081981f * t)); }
__device__ __forceinline__ float silu_f(float x) { return x * __builtin_amdgcn_rcpf(1.0f + __builtin_amdgcn_exp2f(-1.4426950409f * x)); }

struct EpiAin {
    static constexpr bool PERM = true, AFTER_DRAIN = false, IDEM = true;
    bf16_t* O; float* stats;
    __device__ __forceinline__ void operator()(const f32x4 (&acc)[2][2][4][2], const Unit& u, int wr, int wc, int fr, int fq) const {
        const int reg = u.pn >> 4;
        const int row0 = u.pm * BM + wr * 64 + fr, col0 = u.pn * BM + wc * 32 + 8 * fq;
#pragma unroll
        for (int ai = 0; ai < 2; ++ai)
#pragma unroll
            for (int m = 0; m < 4; ++m) {
                const int row = row0 + ai * HALF + m * 16;
                bf16_t* rowp = O + (size_t)row * 12288 + col0;
                float ss = 0.f;
#pragma unroll
                for (int bj = 0; bj < 2; ++bj) {
                    f32x4 v0 = acc[ai][bj][m][0], v1 = acc[ai][bj][m][1];
                    if (reg == 2) {
#pragma unroll
                        for (int e = 0; e < 4; ++e) { v0[e] = silu_f(v0[e]); v1[e] = silu_f(v1[e]); }
                    } else {
#pragma unroll
                        for (int e = 0; e < 4; ++e) { v0[e] = gelu_tanh(v0[e]); v1[e] = gelu_tanh(v1[e]); }
                    }
                    if (reg == 1) ss += (v0[0] * v0[0] + v0[1] * v0[1]) + (v0[2] * v0[2] + v0[3] * v0[3]) + (v1[0] * v1[0] + v1[1] * v1[1]) + (v1[2] * v1[2] + v1[3] * v1[3]);
                    u32x4 w; w.x = cvt_pk_bf16(v0[0], v0[1]); w.y = cvt_pk_bf16(v0[2], v0[3]); w.z = cvt_pk_bf16(v1[0], v1[1]); w.w = cvt_pk_bf16(v1[2], v1[3]);
                    *(u32x4*)(rowp + bj * HALF) = w;
#if defined(PROBE_STORE2)
                    asm volatile("" ::: "memory"); *(u32x4*)(rowp + bj * HALF) = w;
#endif
                }
                if (reg == 1) { ss += shx<16>(ss); ss = add_x32(ss); if (fq == 0) stats[(size_t)row * 64 + (u.pn - 16) * 4 + wc] = ss; }
            }
    }
};
struct EpiBin {
    static constexpr bool PERM = true, AFTER_DRAIN = false, IDEM = true;
    bf16_t* O; const float* st1; float wsc;
    __device__ __forceinline__ void operator()(const f32x4 (&acc)[2][2][4][2], const Unit& u, int wr, int wc, int fr, int fq) const {
        const int reg = u.pn >> 4;
        const int row0 = u.pm * BM + wr * 64 + fr, col0 = u.pn * BM + wc * 32 + 8 * fq;
#pragma unroll
        for (int ai = 0; ai < 2; ++ai)
#pragma unroll
            for (int m = 0; m < 4; ++m) {
                const int row = row0 + ai * HALF + m * 16;
                bf16_t* rowp = O + (size_t)row * 16384 + col0;
                float rs_;
                { const f32x4 a_ = *(const f32x4*)(st1 + (size_t)row * 32 + 8 * fq), b_ = *(const f32x4*)(st1 + (size_t)row * 32 + 8 * fq + 4);
                  float t_ = ((a_[0] + a_[1]) + (a_[2] + a_[3])) + ((b_[0] + b_[1]) + (b_[2] + b_[3])); t_ += shx<16>(t_); t_ = add_x32(t_);
                  rs_ = (1.0f / sqrtf(t_ * (1.0f / 2048.0f) + 1e-6f)) * wsc; }
#pragma unroll
                for (int bj = 0; bj < 2; ++bj) {
                    f32x4 v0 = acc[ai][bj][m][0], v1 = acc[ai][bj][m][1];
                    { const float sc = (reg == 0) ? 0.12751743082f * rs_ : rs_; v0 = v0 * sc; v1 = v1 * sc; }
                    if (reg == 3) {
#pragma unroll
                        for (int e = 0; e < 4; ++e) { v0[e] = silu_f(v0[e]); v1[e] = silu_f(v1[e]); }
                    }
                    u32x4 w; w.x = cvt_pk_bf16(v0[0], v0[1]); w.y = cvt_pk_bf16(v0[2], v0[3]); w.z = cvt_pk_bf16(v1[0], v1[1]); w.w = cvt_pk_bf16(v1[2], v1[3]);
                    *(u32x4*)(rowp + bj * HALF) = w;
#if defined(PROBE_STORE2)
                    asm volatile("" ::: "memory"); *(u32x4*)(rowp + bj * HALF) = w;
#endif
                }
            }
    }
};
struct EpiRes {
    static constexpr bool PERM = false, AFTER_DRAIN = false, IDEM = false;
    const float* base; float* out; float sc;
    __device__ __forceinline__ void operator()(const f32x4 (&acc)[2][2][4][2], const Unit& u, int wr, int wc, int fr, int fq) const {
        const int row0 = u.pm * BM + wr * 64 + fr, col0 = u.pn * BM + wc * 32 + 4 * fq;
#pragma unroll
        for (int ai = 0; ai < 2; ++ai) {
            f32x4 bv[4][2][2];
#pragma unroll
            for (int m = 0; m < 4; ++m) { const size_t off = (size_t)(row0 + ai * HALF + m * 16) * 2048 + col0;
#pragma unroll
                for (int bj = 0; bj < 2; ++bj)
#pragma unroll
                    for (int n = 0; n < 2; ++n) bv[m][bj][n] = *(const f32x4*)(base + off + bj * HALF + n * 16); }
            __builtin_amdgcn_sched_barrier(0);
#pragma unroll
            for (int m = 0; m < 4; ++m) { const size_t off = (size_t)(row0 + ai * HALF + m * 16) * 2048 + col0;
#pragma unroll
                for (int bj = 0; bj < 2; ++bj)
#pragma unroll
                    for (int n = 0; n < 2; ++n) *(f32x4*)(out + off + bj * HALF + n * 16) = bv[m][bj][n] + acc[ai][bj][m][n] * sc; }
        }
    }
};

struct EpiResN {
    static constexpr bool PERM = true, AFTER_DRAIN = false, IDEM = true;
    const float* base; float* out; unsigned char* xn8; float* st1; const float* g1;
    __device__ __forceinline__ void operator()(const f32x4 (&acc)[2][2][4][2], const Unit& u, int wr, int wc, int fr, int fq) const {
        const int row0 = u.pm * BM + wr * 64 + fr, col0 = u.pn * BM + wc * 32 + 8 * fq;
        f32x4 gv[2][2];
#pragma unroll
        for (int bj = 0; bj < 2; ++bj)
#pragma unroll
            for (int n = 0; n < 2; ++n) gv[bj][n] = *(const f32x4*)(g1 + col0 + bj * HALF + 4 * n);
#pragma unroll
        for (int ai = 0; ai < 2; ++ai) {
            f32x4 bv[4][2][2];
#pragma unroll
            for (int m = 0; m < 4; ++m) { const size_t off = (size_t)(row0 + ai * HALF + m * 16) * 2048 + col0;
#pragma unroll
                for (int bj = 0; bj < 2; ++bj) { bv[m][bj][0] = *(const f32x4*)(base + off + bj * HALF); bv[m][bj][1] = *(const f32x4*)(base + off + bj * HALF + 4); } }
            __builtin_amdgcn_sched_barrier(0);
#pragma unroll
            for (int m = 0; m < 4; ++m) {
                const int row = row0 + ai * HALF + m * 16; const size_t off = (size_t)row * 2048 + col0;
                float ss = 0.f;
#pragma unroll
                for (int bj = 0; bj < 2; ++bj) {
                    const f32x4 x0 = bv[m][bj][0] + acc[ai][bj][m][0], x1 = bv[m][bj][1] + acc[ai][bj][m][1];
                    *(f32x4*)(out + off + bj * HALF) = x0; *(f32x4*)(out + off + bj * HALF + 4) = x1;
                    ss += ((x0[0] * x0[0] + x0[1] * x0[1]) + (x0[2] * x0[2] + x0[3] * x0[3])) + ((x1[0] * x1[0] + x1[1] * x1[1]) + (x1[2] * x1[2] + x1[3] * x1[3]));
                    const f32x4 y0 = x0 * gv[bj][0], y1 = x1 * gv[bj][1];
                    unsigned w0 = (unsigned)__builtin_amdgcn_cvt_pk_fp8_f32(y0[0], y0[1], 0, false); w0 = (unsigned)__builtin_amdgcn_cvt_pk_fp8_f32(y0[2], y0[3], (int)w0, true);
                    unsigned w1 = (unsigned)__builtin_amdgcn_cvt_pk_fp8_f32(y1[0], y1[1], 0, false); w1 = (unsigned)__builtin_amdgcn_cvt_pk_fp8_f32(y1[2], y1[3], (int)w1, true);
                    typedef unsigned u32x2_ __attribute__((ext_vector_type(2)));
                    const u32x2_ ww_ = {w0, w1}; *(u32x2_*)(xn8 + off + bj * HALF) = ww_;
                }
                ss += shx<16>(ss); ss = add_x32(ss);
                if (fq == 0) st1[(size_t)row * 32 + u.pn * 4 + wc] = ss;
            }
        }
    }
};
typedef int i32x4 __attribute__((ext_vector_type(4)));
typedef int i32x8 __attribute__((ext_vector_type(8)));
#ifdef F8_DEBUG_UNSCALED
#define F8_MMA_BODY(acc_, afr_, bfr_) { typedef long i64x2_ __attribute__((ext_vector_type(2))); const i64x2_ a0_ = __builtin_bit_cast(i64x2_, (afr_).lo), a1_ = __builtin_bit_cast(i64x2_, (afr_).hi), b0_ = __builtin_bit_cast(i64x2_, (bfr_).lo), b1_ = __builtin_bit_cast(i64x2_, (bfr_).hi); \
            acc_ = __builtin_amdgcn_mfma_f32_16x16x32_fp8_fp8(b0_.x, a0_.x, acc_, 0, 0, 0); acc_ = __builtin_amdgcn_mfma_f32_16x16x32_fp8_fp8(b0_.y, a0_.y, acc_, 0, 0, 0); \
            acc_ = __builtin_amdgcn_mfma_f32_16x16x32_fp8_fp8(b1_.x, a1_.x, acc_, 0, 0, 0); acc_ = __builtin_amdgcn_mfma_f32_16x16x32_fp8_fp8(b1_.y, a1_.y, acc_, 0, 0, 0); }
#else
#define F8_MMA_BODY(acc_, afr_, bfr_) asm volatile("v_mfma_f32_16x16x128_f8f6f4 %0, %1, %2, %0" : "+v"(acc_) : "v"(bfr_), "v"(afr_));
#endif
struct XSync { unsigned* cnt; volatile PG8_LAS unsigned* ep; unsigned n; };
__device__ __forceinline__ void xsync_wait(const XSync& xs, int lane) {
    if (lane == 0) { const unsigned e = xs.ep[0] + 1u; xs.ep[0] = e; __hip_atomic_fetch_add(xs.cnt, 1u, __ATOMIC_RELAXED, __HIP_MEMORY_SCOPE_AGENT);
        const unsigned target = e * xs.n; unsigned spins = 0;
        while (__hip_atomic_load(xs.cnt, __ATOMIC_RELAXED, __HIP_MEMORY_SCOPE_AGENT) < target && ++spins < 3000u) __builtin_amdgcn_s_sleep(1); }
}
template <bool F8> struct Fr;
template <> struct Fr<false> { bf16x8 k[2]; __device__ __forceinline__ void set(int i, bf16x8 x) { k[i] = x; } };
template <> struct Fr<true>  { i32x8 v;     __device__ __forceinline__ void set(int i, bf16x8 x) { const i32x4 y = __builtin_bit_cast(i32x4, x); if (i == 0) v.lo = y; else v.hi = y; } };
template <class Epi, class Sched, bool ALIGN_EPI = false, bool SP2 = false, bool F8 = false, int KREP = 1, bool XSYNC = false>
__device__ __forceinline__ void gemm_phase(PG8_LAS unsigned char* lds, const Gemm g, const Sched& S, const Epi& E, int wid_in, int lane_in, const XSync xs = XSync{nullptr, nullptr, 0u}) {
    const int wid = wid_in, lane = lane_in, tid = wid * 64 + lane, wr = wid >> 2, wc = wid & 3, fr = lane & 15, fq = lane >> 4;
    const int K = g.K, nt = K / BK;
    unsigned voffA[2], voffB[2];
#pragma unroll
    for (int i = 0; i < 2; ++i) { int R, C; stage_rc(tid * 16 + i * 8192, R, C); const int Rb = Epi::PERM ? ((R & ~31) + perm32(R & 31)) : R;
        voffA[i] = (unsigned)(R * K + C) * 2u; voffB[i] = (unsigned)(Rb * K + C) * 2u; }
    const size_t kstep = (size_t)(BK * 2);
    const size_t hstep = (size_t)HALF * K * 2;
    const size_t tstep = 2 * hstep;
    const unsigned ldsw = (unsigned)wid * 1024u;
    const int aoff = lds_byte(wr * 64 + fr, fq * 8), boff = lds_byte(wc * 32 + fr, fq * 8);
#define PG8_SA(b, h) (((b) * 2 + (h)) * HTB)
#define PG8_SB(b, h) ((4 + (b) * 2 + (h)) * HTB)
#define PG8_STAGE(bufoff, gbase, voff) do { _Pragma("unroll") for (int _i = 0; _i < 2; ++_i) \
        __builtin_amdgcn_global_load_lds((const unsigned*)((const char*)(gbase) + (voff)[_i]), (PG8_LAS unsigned*)(lds + (bufoff) + ldsw + _i * 8192), 16, 0, 0); } while (0)
#define PG8_LDA(dst, b, h) do { _Pragma("unroll") for (int m = 0; m < 4; ++m) _Pragma("unroll") for (int k = 0; k < 2; ++k) dst[m].set(k, *(const PG8_LAS bf16x8*)(lds + PG8_SA(b, h) + aoff + m * 2048 + k * 1024)); } while (0)
#define PG8_LDB(dst, b, h) do { _Pragma("unroll") for (int n = 0; n < 2; ++n) _Pragma("unroll") for (int k = 0; k < 2; ++k) dst[n].set(k, *(const PG8_LAS bf16x8*)(lds + PG8_SB(b, h) + boff + n * 2048 + k * 1024)); } while (0)
#define PG8_MMA(ai, bj, At, Bt) do { __builtin_amdgcn_s_setprio(1); _Pragma("unroll") for (int m = 0; m < 4; ++m) _Pragma("unroll") for (int n = 0; n < 2; ++n) { \
        if constexpr (F8) { F8_MMA_BODY(acc[ai][bj][m][n], At[m].v, Bt[n].v) } \
        else { _Pragma("unroll") for (int k = 0; k < 2; ++k) acc[ai][bj][m][n] = __builtin_amdgcn_mfma_f32_16x16x32_bf16(Bt[n].k[k], At[m].k[k], acc[ai][bj][m][n], 0, 0, 0); } } \
        __builtin_amdgcn_s_setprio(0); } while (0)
#define PG8_WAIT_V(n) asm volatile("s_waitcnt vmcnt(" #n ")" ::: "memory")
#define PG8_WAIT_L(n) asm volatile("s_waitcnt lgkmcnt(" #n ")" ::: "memory")
#define PG8_BAR __builtin_amdgcn_s_barrier()
#define PG8_SCHED __builtin_amdgcn_sched_barrier(0)
    Unit cur, nxt; int ui = 0;
    if (!S.next(0, cur)) return;
    f32x4 acc[2][2][4][2];
#pragma unroll
    for (int a = 0; a < 2; ++a)
#pragma unroll
        for (int b = 0; b < 2; ++b)
#pragma unroll
            for (int m = 0; m < 4; ++m)
#pragma unroll
                for (int n = 0; n < 2; ++n) acc[a][b][m][n] = (f32x4){0.f, 0.f, 0.f, 0.f};
    Fr<F8> At[4], B0[2], B1[2];
#define PG8_F8_SETTLE() do { if constexpr (F8) asm volatile("s_nop 15\n\ts_nop 15" ::: "memory"); } while (0)
    const char* cA = (const char*)g.A + (size_t)cur.pm * tstep; const char* cB = (const char*)g.Bt + (size_t)cur.pn * tstep;
    S.a_ready(cur);
    if constexpr (SP2) {
        PG8_STAGE(PG8_SB(0, 0), cB, voffB); PG8_STAGE(PG8_SB(0, 1), cB + hstep, voffB); PG8_STAGE(PG8_SA(0, 0), cA, voffA); PG8_STAGE(PG8_SA(0, 1), cA + hstep, voffA);
        if (wr == 1) PG8_BAR;
        PG8_WAIT_V(2); PG8_BAR;
        PG8_STAGE(PG8_SB(1, 0), cB + kstep, voffB); PG8_STAGE(PG8_SA(1, 0), cA + kstep, voffA); PG8_STAGE(PG8_SB(1, 1), cB + hstep + kstep, voffB);
        PG8_WAIT_V(6); PG8_BAR;
    } else {
        PG8_STAGE(PG8_SB(0, 0), cB, voffB); PG8_STAGE(PG8_SA(0, 0), cA, voffA); PG8_STAGE(PG8_SB(0, 1), cB + hstep, voffB); PG8_STAGE(PG8_SA(0, 1), cA + hstep, voffA);
        if (wr == 1) PG8_BAR;
        PG8_WAIT_V(4); PG8_BAR;
        PG8_STAGE(PG8_SB(1, 0), cB + kstep, voffB); PG8_STAGE(PG8_SA(1, 0), cA + kstep, voffA); PG8_STAGE(PG8_SB(1, 1), cB + hstep + kstep, voffB);
        PG8_WAIT_V(6); PG8_BAR;
    }
    for (;;) {
        const bool has_next = S.next(ui + 1, nxt);
        const char* nA = has_next ? (const char*)g.A + (size_t)nxt.pm * tstep : cA; const char* nB = has_next ? (const char*)g.Bt + (size_t)nxt.pn * tstep : cB;
        for (int kr_ = 0; kr_ < KREP; ++kr_) {
        const bool final_ = (kr_ == KREP - 1); const char* nA_ = final_ ? nA : cA; const char* nB_ = final_ ? nB : cB;
        for (int t = 0; t < nt; t += 2) {
            const bool last = (t == nt - 2);
            const char* a1 = cA + (size_t)(t + 1) * kstep;
            const char* a2 = last ? nA_ : cA + (size_t)(t + 2) * kstep; const char* b2 = last ? nB_ : cB + (size_t)(t + 2) * kstep;
            const char* a3 = a2 + kstep; const char* b3 = b2 + kstep;
            if (last && has_next) S.a_ready(nxt);
            if constexpr (SP2) {
            PG8_LDB(B0, 0, 0); PG8_LDB(B1, 0, 1); PG8_SCHED; PG8_LDA(At, 0, 0); PG8_STAGE(PG8_SA(1, 1), a1 + hstep, voffA);
            PG8_WAIT_V(8); PG8_WAIT_L(0); PG8_BAR; PG8_MMA(0, 0, At, B0); PG8_MMA(0, 1, At, B1); PG8_BAR; PG8_SCHED;
            PG8_LDA(At, 0, 1); PG8_STAGE(PG8_SB(0, 0), b2, voffB); PG8_STAGE(PG8_SB(0, 1), b2 + hstep, voffB); PG8_STAGE(PG8_SA(0, 0), a2, voffA);
            PG8_WAIT_V(8); PG8_WAIT_L(0); PG8_BAR; PG8_MMA(1, 0, At, B0); PG8_MMA(1, 1, At, B1); PG8_BAR; PG8_SCHED;
            PG8_LDB(B0, 1, 0); PG8_LDB(B1, 1, 1); PG8_SCHED; PG8_LDA(At, 1, 0); PG8_STAGE(PG8_SA(0, 1), a2 + hstep, voffA);
            PG8_WAIT_V(8); PG8_WAIT_L(0); PG8_BAR; PG8_MMA(0, 0, At, B0); PG8_MMA(0, 1, At, B1); PG8_BAR; PG8_SCHED;
            PG8_LDA(At, 1, 1); PG8_STAGE(PG8_SB(1, 0), b3, voffB); PG8_STAGE(PG8_SB(1, 1), b3 + hstep, voffB); PG8_STAGE(PG8_SA(1, 0), a3, voffA);
            PG8_WAIT_V(8); PG8_WAIT_L(0); PG8_BAR; PG8_MMA(1, 0, At, B0); PG8_MMA(1, 1, At, B1); PG8_BAR; PG8_SCHED;
            } else {
            PG8_LDB(B0, 0, 0); PG8_SCHED; PG8_LDA(At, 0, 0); PG8_STAGE(PG8_SA(1, 1), a1 + hstep, voffA);
            PG8_WAIT_L(8); PG8_BAR; PG8_WAIT_L(0); PG8_MMA(0, 0, At, B0); PG8_BAR; PG8_SCHED;
            PG8_LDB(B1, 0, 1); PG8_STAGE(PG8_SB(0, 0), b2, voffB);
            PG8_BAR; PG8_WAIT_L(0); PG8_MMA(0, 1, At, B1); PG8_BAR;
            PG8_LDA(At, 0, 1); PG8_STAGE(PG8_SA(0, 0), a2, voffA);
            PG8_BAR; PG8_WAIT_L(0); PG8_MMA(1, 0, At, B0); PG8_BAR; PG8_SCHED;
            PG8_STAGE(PG8_SB(0, 1), b2 + hstep, voffB);
            PG8_WAIT_V(6); PG8_BAR; PG8_MMA(1, 1, At, B1); PG8_BAR;
            PG8_LDB(B0, 1, 0); PG8_SCHED; PG8_LDA(At, 1, 0); PG8_STAGE(PG8_SA(0, 1), a2 + hstep, voffA);
            PG8_WAIT_L(8); PG8_BAR; PG8_WAIT_L(0); PG8_MMA(0, 0, At, B0); PG8_BAR; PG8_SCHED;
            PG8_LDB(B1, 1, 1); PG8_STAGE(PG8_SB(1, 0), b3, voffB);
            PG8_BAR; PG8_WAIT_L(0); PG8_MMA(0, 1, At, B1); PG8_BAR;
            PG8_LDA(At, 1, 1); PG8_STAGE(PG8_SA(1, 0), a3, voffA);
            PG8_BAR; PG8_WAIT_L(0); PG8_MMA(1, 0, At, B0); PG8_BAR; PG8_SCHED;
            PG8_STAGE(PG8_SB(1, 1), b3 + hstep, voffB);
            PG8_WAIT_V(6); PG8_BAR; PG8_MMA(1, 1, At, B1); PG8_BAR;
            }
        }
        if (!final_) { PG8_F8_SETTLE();
#if defined(PROBE_EPI_IN_KREP)
            if constexpr (Epi::IDEM) { if constexpr (ALIGN_EPI) { if (wr == 0) PG8_BAR; } E(acc, cur, wr, wc, fr, fq); if constexpr (ALIGN_EPI) { if (wr == 1) PG8_BAR; } }
#endif
            _Pragma("unroll") for (int a = 0; a < 2; ++a) _Pragma("unroll") for (int b = 0; b < 2; ++b) _Pragma("unroll") for (int m = 0; m < 4; ++m) _Pragma("unroll") for (int n = 0; n < 2; ++n) acc[a][b][m][n] = (f32x4){0.f, 0.f, 0.f, 0.f}; }
        }
        PG8_F8_SETTLE();
        if constexpr (ALIGN_EPI) { if (wr == 0) PG8_BAR; }
#ifndef PG8_EREP
#define PG8_EREP 1
#endif
        if constexpr (!Epi::AFTER_DRAIN) { E(acc, cur, wr, wc, fr, fq);
            if constexpr (PG8_EREP > 1 && Epi::IDEM) { asm volatile("s_waitcnt vmcnt(0)" ::: "memory"); E(acc, cur, wr, wc, fr, fq); }
            S.done(cur); }
        if (!has_next) break;
#pragma unroll
        for (int a = 0; a < 2; ++a)
#pragma unroll
            for (int b = 0; b < 2; ++b)
#pragma unroll
                for (int m = 0; m < 4; ++m)
#pragma unroll
                    for (int n = 0; n < 2; ++n) acc[a][b][m][n] = (f32x4){0.f, 0.f, 0.f, 0.f};
        cur = nxt; cA = nA; cB = nB; ++ui;
        if constexpr (XSYNC && ALIGN_EPI) { if (wid == 0) xsync_wait(xs, lane); asm volatile("" ::: "memory"); PG8_BAR; }
        if constexpr (ALIGN_EPI) { if (wr == 1) PG8_BAR; }
    }
    PG8_WAIT_V(0);
    if constexpr (!ALIGN_EPI) { if (wr == 0) PG8_BAR; }
    PG8_BAR;
    if constexpr (Epi::AFTER_DRAIN) { E.fused(acc, cur, wr, wc, fr, fq, lds, wid, lane); S.done(cur); }
#undef PG8_SA
#undef PG8_SB
#undef PG8_STAGE
#undef PG8_LDA
#undef PG8_LDB
#undef PG8_MMA
#undef PG8_WAIT_V
#undef PG8_WAIT_L
#undef PG8_BAR
#undef PG8_SCHED
}
}
#define GAS __attribute__((address_space(1)))
#define LAS __attribute__((address_space(3)))
typedef unsigned short bf16;
typedef unsigned v4u __attribute__((ext_vector_type(4)));
typedef float f32x4 __attribute__((ext_vector_type(4)));
typedef short bf16x8 __attribute__((ext_vector_type(8)));
typedef GAS unsigned gu32;
typedef GAS unsigned long long gu64;
#define RLX_AGENT __ATOMIC_RELAXED, __HIP_MEMORY_SCOPE_AGENT
#define LDS_WAIT() asm volatile("s_waitcnt lgkmcnt(0)" ::: "memory")
#define VM_WAIT() asm volatile("s_waitcnt vmcnt(0)" ::: "memory")
__device__ __forceinline__ unsigned long long rt() { return __builtin_amdgcn_s_memrealtime(); }
__device__ __forceinline__ unsigned f2bf(float f) { unsigned u = __builtin_bit_cast(unsigned, f); return (u + 0x7fffu + ((u >> 16) & 1u)) >> 16; }
__device__ __forceinline__ unsigned pk2(float lo, float hi) { return f2bf(lo) | (f2bf(hi) << 16); }
#define XB_TMO      128
#define XB_XCNT(j)  (256  + 64 * (j))
#define XB_XSUB(j)  (1280 + 64 * (j))
#define XB_XGEN(j)  (2304 + 64 * (j))
#define XB_TOP      3328
#define XB_TOPGEN   3392
#define XCD_BAR_WORDS 3456
#define XB_SPIN_CAP (1u << 18)

__device__ __forceinline__ unsigned xb_ld(unsigned* p)              { return __hip_atomic_load(p, __ATOMIC_RELAXED, __HIP_MEMORY_SCOPE_AGENT); }
__device__ __forceinline__ unsigned xb_add(unsigned* p, unsigned v) { return __hip_atomic_fetch_add(p, v, __ATOMIC_RELAXED, __HIP_MEMORY_SCOPE_AGENT); }
__device__ __forceinline__ unsigned xb_xcc_id() { return (unsigned)__builtin_amdgcn_s_getreg((3 << 11) | 20) & 0xFu; }
#define XB_SPIN(cond, bar) do { unsigned _sp = 0; while (cond) { __builtin_amdgcn_s_sleep(1); \
    if ((++_sp & 255u) == 0u) { if (xb_ld(&(bar)[XB_TMO])) break; if (_sp > XB_SPIN_CAP) { atomicAdd(&(bar)[XB_TMO], 1u); break; } } } } while (0)

struct XcdBarrier {
    unsigned* bar; unsigned x;
    volatile LAS unsigned* st;
};

__device__ __forceinline__ XcdBarrier xcd_barrier_post(unsigned* bar, volatile LAS unsigned* st) {
    XcdBarrier b; b.bar = bar; b.x = xb_xcc_id(); b.st = st;
    if (threadIdx.x == 0) (void)xb_add(&bar[XB_XCNT(b.x)], 1u);
    return b;
}
__device__ __forceinline__ void xcd_barrier_complete(unsigned* bar, unsigned x, unsigned& nloc, unsigned& nx) {
    const unsigned G = gridDim.x * gridDim.y * gridDim.z;
    unsigned sum, cnt, mine, sp = 0u;
    for (;;) {
        sum = 0u; cnt = 0u; mine = 0u;
#pragma unroll
        for (unsigned j = 0; j < 16; ++j) { const unsigned c = xb_ld(&bar[XB_XCNT(j)]); sum += c; cnt += (c > 0u) ? 1u : 0u; mine = (j == x) ? c : mine; }
        if (sum == G) break;
        __builtin_amdgcn_s_sleep(1);
        if ((++sp & 255u) == 0u) { if (xb_ld(&bar[XB_TMO])) break; if (sp > XB_SPIN_CAP) { atomicAdd(&bar[XB_TMO], 1u); break; } }
    }
    nloc = mine > 0u ? mine : 1u; nx = cnt > 0u ? cnt : 1u;
}

__device__ __forceinline__ void xcd_barrier(const XcdBarrier& b) {
    asm volatile("s_waitcnt vmcnt(0)" ::: "memory");
    __syncthreads();
    if (threadIdx.x == 0) {
        unsigned* bar = b.bar;
        __builtin_amdgcn_s_waitcnt(0);
        unsigned nloc = b.st[0], nx = b.st[1];
        if (nloc == 0u) { xcd_barrier_complete(bar, b.x, nloc, nx); b.st[0] = nloc; b.st[1] = nx; }
        const unsigned old = xb_add(&bar[XB_XSUB(b.x)], 1u);
        const unsigned gen = old / nloc;
        if (old + 1u == (gen + 1u) * nloc) {
            __builtin_amdgcn_fence(__ATOMIC_RELEASE, "agent");
            asm volatile("s_waitcnt vmcnt(0)" ::: "memory");
            const unsigned og = xb_add(&bar[XB_TOP], 1u);
            const unsigned tg = og / nx;
            if (og + 1u == (tg + 1u) * nx) xb_add(&bar[XB_TOPGEN], 1u);
            else XB_SPIN(xb_ld(&bar[XB_TOPGEN]) == tg, bar);
            __builtin_amdgcn_fence(__ATOMIC_ACQUIRE, "agent");
            xb_add(&bar[XB_XGEN(b.x)], 1u);
            asm volatile("s_waitcnt vmcnt(0)" ::: "memory");
        } else {
            XB_SPIN(xb_ld(&bar[XB_XGEN(b.x)]) == gen, bar);
            __builtin_amdgcn_fence(__ATOMIC_ACQUIRE, "agent");
            asm volatile("s_waitcnt vmcnt(0)" ::: "memory");
        }
    }
    __syncthreads();
}
__device__ __forceinline__ float wave_sum(float v) {
    v += shx<1>(v); v += shx<2>(v); v += shx<4>(v); v += shx<8>(v); v += shx<16>(v); v = add_x32(v);
    return v;
}
__device__ __forceinline__ float fp8rt(float x) { const int p = __builtin_amdgcn_cvt_pk_fp8_f32(x, x, 0, false); return __builtin_amdgcn_cvt_f32_fp8(p, 0); }
template <bool Q8>
__device__ __forceinline__ void p0_transpose_item(const float* W, int K, int N, bf16* WT, int row_off, LAS float* scr, int item, int lane) {
    const int nblk = N / 32, kb = item / nblk, nb = item % nblk, k0 = 64 * kb, n0 = 32 * nb;
    float wv_[32];
#pragma unroll
    for (int i = 0; i < 32; ++i) { const int kk = 2 * i + (lane >> 5); wv_[i] = W[(size_t)(k0 + kk) * N + n0 + (lane & 31)]; }
#pragma unroll
    for (int i = 0; i < 32; ++i) { const int kk = 2 * i + (lane >> 5); float w1_ = wv_[i]; if (Q8) w1_ = fp8rt(w1_ * 32.0f) * 0.03125f; scr[kk * 33 + (lane & 31)] = w1_; }
    LDS_WAIT(); asm volatile("" ::: "memory");
    const int c = lane & 7;
#pragma unroll
    for (int j = 0; j < 4; ++j) { const int n = (lane >> 3) + 8 * j; const LAS float* s = scr + (8 * c) * 33 + n;
        v4u o; o.x = pk2(s[0 * 33], s[1 * 33]); o.y = pk2(s[2 * 33], s[3 * 33]); o.z = pk2(s[4 * 33], s[5 * 33]); o.w = pk2(s[6 * 33], s[7 * 33]);
        *(GAS v4u*)(WT + (size_t)(row_off + n0 + n) * K + k0 + 8 * c) = o; }
    LDS_WAIT(); asm volatile("" ::: "memory");
}

__device__ __forceinline__ unsigned pk4_fp8(float a, float b, float c, float d) { int w = __builtin_amdgcn_cvt_pk_fp8_f32(a, b, 0, false); w = __builtin_amdgcn_cvt_pk_fp8_f32(c, d, w, true); return (unsigned)w; }
__device__ __forceinline__ void p0_transpose_item_f8(const float* W, int K, int N, unsigned char* WT, float wscale, LAS float* scr, int item, int lane) {
    const int nblk = N / 32, kb = item / nblk, nb = item % nblk, k0 = 64 * kb, n0 = 32 * nb;
    float wv_[32];
#pragma unroll
    for (int i = 0; i < 32; ++i) { const int kk = 2 * i + (lane >> 5); wv_[i] = W[(size_t)(k0 + kk) * N + n0 + (lane & 31)]; }
#pragma unroll
    for (int i = 0; i < 32; ++i) { const int kk = 2 * i + (lane >> 5); scr[kk * 33 + (lane & 31)] = wv_[i] * wscale; }
    LDS_WAIT(); asm volatile("" ::: "memory");
    const int n = lane >> 1, hb = lane & 1; const LAS float* s = scr + (32 * hb) * 33 + n;
    v4u o0, o1;
    o0.x = pk4_fp8(s[0 * 33], s[1 * 33], s[2 * 33], s[3 * 33]);     o0.y = pk4_fp8(s[4 * 33], s[5 * 33], s[6 * 33], s[7 * 33]);
    o0.z = pk4_fp8(s[8 * 33], s[9 * 33], s[10 * 33], s[11 * 33]);   o0.w = pk4_fp8(s[12 * 33], s[13 * 33], s[14 * 33], s[15 * 33]);
    o1.x = pk4_fp8(s[16 * 33], s[17 * 33], s[18 * 33], s[19 * 33]); o1.y = pk4_fp8(s[20 * 33], s[21 * 33], s[22 * 33], s[23 * 33]);
    o1.z = pk4_fp8(s[24 * 33], s[25 * 33], s[26 * 33], s[27 * 33]); o1.w = pk4_fp8(s[28 * 33], s[29 * 33], s[30 * 33], s[31 * 33]);
    GAS v4u* dst = (GAS v4u*)(WT + (size_t)(n0 + n) * K + k0 + 32 * hb); dst[0] = o0; dst[1] = o1;
    LDS_WAIT(); asm volatile("" ::: "memory");
}

constexpr int NWAVES = 8;
constexpr int D = 2048, E = 4096, NA = 3 * E, NB = 4 * E, TP = 8192, TS = 16384, NTOK = TP + 2 * TS, MC = 16384;
constexpr int GRIDW = 64, NHEAD = 32, HD = 128;
constexpr float EPS = 1e-6f;
constexpr size_t MiB = 1u << 20;
constexpr size_t WS_CTL = 0, CTL_ZERO_BYTES = 65536;
constexpr size_t WS_WAIN = 1 * MiB;
constexpr size_t WS_WAOUT = 49 * MiB;
constexpr size_t WS_WBIN = 65 * MiB;
constexpr size_t WS_WBOUT = 97 * MiB;
constexpr size_t WS_XN0 = 105 * MiB;
constexpr size_t WS_XN = 265 * MiB;
constexpr size_t WS_STATS = 297 * MiB;
constexpr size_t WS_STATS1 = 301 * MiB;
constexpr size_t WS_Y = 303 * MiB;
constexpr size_t WS_PROJ = 431 * MiB;
constexpr size_t WS_END = 943 * MiB;
constexpr int CW_BAR = 4096;
static_assert((CW_BAR + XCD_BAR_WORDS) * 4 <= (int)CTL_ZERO_BYTES, "CTL words inside the memset region");
constexpr int RING_BYTES = 131072;
constexpr int LDSCTL_OFF = RING_BYTES, MISC_OFF = LDSCTL_OFF + 320;
constexpr int LDS_BYTES = 147456;
static_assert(MISC_OFF + 128 <= LDS_BYTES, "LDS map");

__device__ __forceinline__ float bf2f(unsigned short b) { return __builtin_bit_cast(float, (unsigned)b << 16); }
__device__ __forceinline__ float bflo(unsigned w) { return __builtin_bit_cast(float, w << 16); }
__device__ __forceinline__ float bfhi(unsigned w) { return __builtin_bit_cast(float, w & 0xffff0000u); }
typedef __bf16 bf16x2_t __attribute__((ext_vector_type(2)));
__device__ __forceinline__ float dot2bf(unsigned a, unsigned b, float acc) { return __builtin_amdgcn_fdot2_f32_bf16(__builtin_bit_cast(bf16x2_t, a), __builtin_bit_cast(bf16x2_t, b), acc, false); }

template <bool Q8>
__device__ __forceinline__ void rms_row_to_bf16(const float* xrow, const float* g, bf16* orow, int lane) {
    const f32x4* xr = (const f32x4*)xrow + lane; const f32x4* gr = (const f32x4*)g + lane;
    f32x4 v[8]; float s = 0.f;
#pragma unroll
    for (int j = 0; j < 8; ++j) { v[j] = xr[64 * j]; s += (v[j].x * v[j].x + v[j].y * v[j].y) + (v[j].z * v[j].z + v[j].w * v[j].w); }
    const float inv = 1.0f / sqrtf(wave_sum(s) * (1.f / D) + EPS);
    unsigned long long* o8 = (unsigned long long*)orow + lane;
#pragma unroll
    for (int j = 0; j < 8; ++j) { const f32x4 gg = gr[64 * j]; f32x4 o = (v[j] * inv) * gg; if (Q8) { o.x = fp8rt(o.x); o.y = fp8rt(o.y); o.z = fp8rt(o.z); o.w = fp8rt(o.w); }
        o8[64 * j] = (unsigned long long)pk2(o.x, o.y) | ((unsigned long long)pk2(o.z, o.w) << 32); }
}
__device__ __forceinline__ void rms_row_to_fp8(const float* xrow, const float* g, unsigned char* orow, int lane) {
    const f32x4* xr = (const f32x4*)xrow + lane; const f32x4* gr = (const f32x4*)g + lane;
    f32x4 v[8]; float s = 0.f;
#pragma unroll
    for (int j = 0; j < 8; ++j) { v[j] = xr[64 * j]; s += (v[j].x * v[j].x + v[j].y * v[j].y) + (v[j].z * v[j].z + v[j].w * v[j].w); }
    const float inv = 1.0f / sqrtf(wave_sum(s) * (1.f / D) + EPS);
    unsigned* o4 = (unsigned*)orow + lane;
#pragma unroll
    for (int j = 0; j < 8; ++j) { const f32x4 gg = gr[64 * j]; const f32x4 o = (v[j] * inv) * gg; o4[64 * j] = pk4_fp8(o.x, o.y, o.z, o.w); }
}
__device__ __forceinline__ void rms_row_inplace(float* xrow, const float* g, int lane) {
    f32x4* xr = (f32x4*)xrow + lane; const f32x4* gr = (const f32x4*)g + lane;
    f32x4 v[8]; float s = 0.f;
#pragma unroll
    for (int j = 0; j < 8; ++j) { v[j] = xr[64 * j]; s += (v[j].x * v[j].x + v[j].y * v[j].y) + (v[j].z * v[j].z + v[j].w * v[j].w); }
    const float inv = 1.0f / sqrtf(wave_sum(s) * (1.f / D) + EPS);
#pragma unroll
    for (int j = 0; j < 8; ++j) { const f32x4 gg = gr[64 * j]; xr[64 * j] = (v[j] * inv) * gg; }
}

typedef short s16x4 __attribute__((ext_vector_type(4)));
typedef unsigned u32x2 __attribute__((ext_vector_type(2)));
__device__ __forceinline__ s16x4 tr16(const LAS unsigned char* p) { return __builtin_bit_cast(s16x4, __builtin_amdgcn_ds_read_tr16_b64_v4i16((LAS s16x4*)p)); }
#ifndef USE_F8
#define USE_F8 true
#endif
#ifndef FP8_EMUL
#define FP8_EMUL false
#endif
#ifndef XSYNC_ON
#define XSYNC_ON false
#endif
#ifndef KREP_A2
#define KREP_A2 1
#endif
#ifndef KREP_A4
#define KREP_A4 1
#endif
#ifndef KREP_B2
#define KREP_B2 1
#endif
#ifndef REP_A2
#define REP_A2 1
#endif
#ifndef REP_A4
#define REP_A4 1
#endif
#ifndef REP_B2
#define REP_B2 1
#endif
#ifndef REP_P0
#define REP_P0 1
#endif
#ifndef REP_A3
#define REP_A3 1
#endif
#ifndef REP_B3
#define REP_B3 1
#endif
struct Args { const float* in[12]; float* out; unsigned char* ws; };

__global__ void __launch_bounds__(NWAVES * 64, 2) fwd(Args args) {
    extern __shared__ __attribute__((aligned(16))) unsigned char lds_raw[];
    LAS unsigned char* lds = (LAS unsigned char*)lds_raw;
    volatile LAS unsigned* MISC = (volatile LAS unsigned*)(lds + MISC_OFF);
    const int wave0 = __builtin_amdgcn_readfirstlane((int)threadIdx.x >> 6);
    const int G = gridDim.x; const int bx = blockIdx.x; const int vcu = (G % 8 == 0) ? (bx % 8) * (G / 8) + bx / 8 : bx;
    const int NGW = G * NWAVES;
#define FRESH_S(x) asm volatile("" : "+s"(x))
#define FRESH_V(x) asm volatile("" : "+v"(x))
#define PHASE_PTRS() size_t z_ = 0; FRESH_S(z_); unsigned char* ws = args.ws + z_; int lane; asm volatile("v_mbcnt_lo_u32_b32 %0, -1, 0\n\tv_mbcnt_hi_u32_b32 %0, -1, %0" : "=v"(lane)); int wave = wave0; FRESH_S(wave); const int tid = wave * 64 + lane, gw = vcu * NWAVES + wave; (void)tid; (void)gw; \
    bf16* WAIN = (bf16*)(ws + WS_WAIN); bf16* WAOUT = (bf16*)(ws + WS_WAOUT); bf16* WBIN = (bf16*)(ws + WS_WBIN); bf16* WBOUT = (bf16*)(ws + WS_WBOUT); \
    bf16* XN = (bf16*)(ws + WS_XN); bf16* XN0 = (bf16*)(ws + WS_XN0); float* STATS = (float*)(ws + WS_STATS); float* STATS1 = (float*)(ws + WS_STATS1); bf16* Y = (bf16*)(ws + WS_Y); bf16* PROJ = (bf16*)(ws + WS_PROJ); \
    (void)WAIN; (void)WAOUT; (void)WBIN; (void)WBOUT; (void)XN; (void)XN0; (void)STATS; (void)STATS1; (void)Y; (void)PROJ; (void)lane
#define XSYNC_OF(bank_) pg8::XSync{(unsigned*)(args.ws + WS_CTL) + 8192 + 512 * (bank_) + 64 * (bx & 7), MISC + 16 + (bank_), (unsigned)((G + 7 - (bx & 7)) >> 3)}
#define GRID_BAR() do { XcdBarrier b_ = bar; size_t zb_ = 0; FRESH_S(zb_); b_.bar = bar.bar + zb_; xcd_barrier(b_); } while (0)
    for (int u = threadIdx.x; u < (LDS_BYTES - LDSCTL_OFF) / 4; u += NWAVES * 64) ((LAS unsigned*)(lds + LDSCTL_OFF))[u] = 0u;
    __syncthreads();
    XcdBarrier bar = xcd_barrier_post((unsigned*)(args.ws + WS_CTL) + CW_BAR, MISC + 8);

#ifndef SKIP_P0
    for (int repp_ = 0; repp_ < REP_P0; ++repp_) {
        PHASE_PTRS();
        LAS float* scr = (LAS float*)(lds + wave * 16384);
        constexpr int I_AIN = (D / 64) * (NA / 32), I_AOUT = (E / 64) * (D / 32), I_BIN = (D / 64) * (NB / 32), I_BOUT = (E / 64) * (D / 32);
        constexpr int NITEMS = I_AIN + I_AOUT + I_BIN + I_BOUT;
        for (int it = gw; it < NITEMS; it += NGW) {
            int r = it;
            if (r < I_AIN) { p0_transpose_item<false>(args.in[4], D, NA, WAIN, 0, scr, r, lane); continue; } r -= I_AIN;
            if (r < I_AOUT) { p0_transpose_item<false>(args.in[8], E, D, WAOUT, 0, scr, r, lane); continue; } r -= I_AOUT;
            if (r < I_BIN) { if (USE_F8) p0_transpose_item_f8(args.in[9], D, NB, (unsigned char*)WBIN, 32.0f, scr, r, lane); else p0_transpose_item<false>(args.in[9], D, NB, WBIN, 0, scr, r, lane); continue; } r -= I_BIN;
            p0_transpose_item_f8(args.in[11], E, D, (unsigned char*)WBOUT, 32.0f, scr, r, lane);
        }
        for (int row = gw; row < NTOK; row += NGW) { const float* xr = (row < TP) ? args.in[0] + (size_t)row * D : args.in[1] + (size_t)(row - TP) * D; rms_row_to_bf16<false>(xr, args.in[2], XN0 + (size_t)row * D, lane); }
    }
#endif
    GRID_BAR();

    for (int sc = 0; sc < 3; ++sc) {
        const int M = (sc == 0) ? TP : TS;
        const int r0 = (sc == 0) ? 0 : TP + (sc - 1) * TS;
        const float* xin = (sc == 0) ? args.in[0] : args.in[1] + (size_t)(sc - 1) * TS * D;
        float* xo = args.out + (size_t)r0 * D;

        for (int repg_ = 0; repg_ < REP_A2; ++repg_) {
            PHASE_PTRS();
            pg8::Gemm g{XN0 + (size_t)r0 * D, WAIN, M, NA, D}; pg8::StaticOrder S; S.init(M, NA, G, bx);
            pg8::EpiAin Ep{PROJ, STATS};
            pg8::gemm_phase<pg8::EpiAin, pg8::StaticOrder, true, true, false, KREP_A2, XSYNC_ON>(lds, g, S, Ep, wave, lane, XSYNC_OF(0));
        }
        GRID_BAR();

#ifndef SKIP_A3
        for (int rep_ = 0; rep_ < REP_A3; ++rep_) {
            PHASE_PTRS();
            LAS unsigned char* VT = lds;
            LAS unsigned char* WN = lds + 69632;
            LAS float* INV = (LAS float*)(lds + 102400);
            const int grp = bx & 15, cgrp = wave & 3, phalf = wave >> 2;
            const float* Wsg = args.in[6] + (size_t)grp * 16384;
            const int nchunk = M / 128;
            for (int chunk = bx >> 4; chunk < nchunk; chunk += (G >> 4)) {
                const int rowbase = chunk * 128;
                int tidc = tid; FRESH_V(tidc); const int lanec = tidc & 63, g16 = lanec >> 4, i16 = lanec & 15;
                {
                    const int row = tidc >> 2, part = tidc & 3; const f32x4* sp = (const f32x4*)(STATS + (size_t)(rowbase + row) * 64 + part * 16);
                    const f32x4 a = sp[0], b = sp[1], c4 = sp[2], d4 = sp[3];
                    float s = (((a.x + a.y) + (a.z + a.w)) + ((b.x + b.y) + (b.z + b.w))) + (((c4.x + c4.y) + (c4.z + c4.w)) + ((d4.x + d4.y) + (d4.z + d4.w)));
                    s += shx<1>(s); s += shx<2>(s);
                    if (part == 0) INV[row] = 1.0f / sqrtf(s * (1.f / E) + EPS);
                }
                {
                    v4u vv[8];
#pragma unroll
                    for (int i = 0; i < 8; ++i) { const int id = tidc + 512 * i, row = id >> 5, ch = id & 31; vv[i] = *(const v4u*)(PROJ + (size_t)(rowbase + row) * NA + E + grp * 256 + ch * 8); }
#pragma unroll
                    for (int i = 0; i < 8; ++i) { const int id = tidc + 512 * i, row = id >> 5, ch = id & 31; *(LAS v4u*)(VT + row * 544 + ch * 16) = vv[i]; }
                }
                __syncthreads();
#pragma unroll
                for (int i = 0; i < 8; ++i) {
                    const int id = tidc + 512 * i, p = id >> 5, j = id & 31;
                    const f32x4 w = *(const f32x4*)(Wsg + p * 128 + 4 * j); const f32x4 iv = *(const LAS f32x4*)(INV + 4 * j);
                    const unsigned lo = pg8::cvt_pk_bf16(w.x * iv.x, w.y * iv.y), hi = pg8::cvt_pk_bf16(w.z * iv.z, w.w * iv.w);
                    const int j7 = j & 7, gg = j7 & 3, e0 = (j7 >> 2) * 4, ks = j >> 3, pt = p >> 4, lanep = gg * 16 + (p & 15);
                    LAS unsigned* dst = (LAS unsigned*)(WN + ((pt * 4 + ks) * 64 + lanep) * 16 + e0 * 2); dst[0] = lo; dst[1] = hi;
                }
                __syncthreads();
                f32x4 acc[4][4];
#pragma unroll
                for (int a = 0; a < 4; ++a)
#pragma unroll
                    for (int b = 0; b < 4; ++b) acc[a][b] = (f32x4){0.f, 0.f, 0.f, 0.f};
#pragma unroll
                for (int ks = 0; ks < 4; ++ks) {
                    bf16x8 bfr[4];
#pragma unroll
                    for (int pt = 0; pt < 4; ++pt) bfr[pt] = *(const LAS bf16x8*)(WN + (((4 * phalf + pt) * 4 + ks) * 64 + lanec) * 16);
#pragma unroll
                    for (int ct = 0; ct < 4; ++ct) {
                        const LAS unsigned char* base = VT + (32 * ks + 4 * g16 + (i16 >> 2)) * 544 + ((4 * cgrp + ct) * 16 + 4 * (i16 & 3)) * 2;
                        const s16x4 lo = tr16(base), hi = tr16(base + 16 * 544);
                        const bf16x8 afr = (bf16x8){lo[0], lo[1], lo[2], lo[3], hi[0], hi[1], hi[2], hi[3]};
#pragma unroll
                        for (int pt = 0; pt < 4; ++pt) acc[ct][pt] = __builtin_amdgcn_mfma_f32_16x16x32_bf16(afr, bfr[pt], acc[ct][pt], 0, 0, 0);
                    }
                }
                __syncthreads();
#pragma unroll
                for (int pt = 0; pt < 4; ++pt) {
                    const int p = (4 * phalf + pt) * 16 + i16; const size_t row = (size_t)(rowbase + p); const float bsv = args.in[7][grp * 128 + p];
#pragma unroll
                    for (int ct = 0; ct < 4; ++ct) {
                        const int c = grp * 256 + (4 * cgrp + ct) * 16 + 4 * g16;
                        const uint2 u2 = *(const uint2*)(PROJ + row * NA + c), z2 = *(const uint2*)(PROJ + row * NA + 2 * E + c); const f32x4 vg = *(const f32x4*)(args.in[5] + c);
                        const f32x4 a = acc[ct][pt];
                        const float y0 = bflo(u2.x) * (a.x * vg.x + bsv) * bflo(z2.x), y1 = bfhi(u2.x) * (a.y * vg.y + bsv) * bfhi(z2.x);
                        const float y2 = bflo(u2.y) * (a.z * vg.z + bsv) * bflo(z2.y), y3 = bfhi(u2.y) * (a.w * vg.w + bsv) * bfhi(z2.y);
                        uint2 o; o.x = pg8::cvt_pk_bf16(y0, y1); o.y = pg8::cvt_pk_bf16(y2, y3);
                        *(uint2*)(Y + row * E + c) = o;
                    }
                }
            }
        }
#endif
        GRID_BAR();

        for (int repg_ = 0; repg_ < REP_A4; ++repg_) {
            PHASE_PTRS();
            pg8::Gemm g{Y, WAOUT, M, D, E}; pg8::StaticOrder S; S.init(M, D, G, bx);
            pg8::EpiResN Ep{xin, xo, (unsigned char*)XN, STATS1, args.in[2] + D};
            pg8::gemm_phase<pg8::EpiResN, pg8::StaticOrder, true, true, false, KREP_A4, XSYNC_ON>(lds, g, S, Ep, wave, lane, XSYNC_OF(1));
        }
        GRID_BAR();

        for (int repg_ = 0; repg_ < REP_B2; ++repg_) {
            PHASE_PTRS();
            pg8::Gemm g{XN, WBIN, M, NB, USE_F8 ? D / 2 : D}; pg8::StaticOrder S; S.init(M, NB, G, bx);
            pg8::EpiBin Ep{PROJ, STATS1, USE_F8 ? 0.03125f : 1.0f};
            pg8::gemm_phase<pg8::EpiBin, pg8::StaticOrder, true, true, USE_F8, KREP_B2, XSYNC_ON>(lds, g, S, Ep, wave, lane, XSYNC_OF(2));
        }
        GRID_BAR();

#ifndef SKIP_B3
        for (int rep_ = 0; rep_ < REP_B3; ++rep_) {
            PHASE_PTRS();
            const int g16 = lane >> 4, i16 = lane & 15;
            const int R = M / GRIDW;
            const int rsel = wave >> 2, qb = wave & 3;
            LAS unsigned char* RING = lds;
            LAS float* RPB = (LAS float*)(lds + 132096) + 64;
            const int c = 16 * qb + i16, cs = min(max(c - 8, 0), GRIDW - 16), kc0 = min(max(16 * qb - 8, 0), 32), thr = cs - kc0;
            int coff[4]; unsigned msk[2] = {0u, 0u}; bool in0[4];
#pragma unroll
            for (int e = 0; e < 4; ++e) { in0[e] = (4 * g16 + e >= thr); coff[e] = kc0 + (in0[e] ? 0 : 16) + 4 * g16 + e - c + 15; if (in0[e]) msk[e >> 1] |= (e & 1) ? 0xffff0000u : 0x0000ffffu; }
            int offk[2], offv[2];
#pragma unroll
            for (int j = 0; j < 2; ++j) { const int lr = 4 * (8 * j + wave) + (lane >> 4), ch = lane & 15; offk[j] = lr * NB + ((ch ^ (lr & 15)) << 3); offv[j] = lr * NB + ((ch ^ ((lr & 7) << 1)) << 3); }
#define B3_GLDS(slot_, gb_, offs_) do { _Pragma("unroll") for (int j_ = 0; j_ < 2; ++j_) \
        __builtin_amdgcn_global_load_lds((const unsigned*)((gb_) + (offs_)[j_]), (LAS unsigned*)(RING + (slot_) * 16384 + (8 * j_ + wave) * 1024), 16, 0, 0); } while (0)
#define B3_ISSUE(pos_, rp_, ru_, slot_) do { \
        if ((pos_) < 2)       { const bf16* gb_ = Pq + (size_t)((2 * (rp_) + (pos_)) * GRIDW) * NB;        B3_GLDS(slot_, gb_, offk); } \
        else if ((pos_) < 11) { const bf16* gb_ = Pk + (size_t)(((ru_) + (pos_) - 2) * GRIDW) * NB;        B3_GLDS(slot_, gb_, offk); } \
        else if ((pos_) < 20) { const bf16* gb_ = Pv + (size_t)(((ru_) + (pos_) - 11) * GRIDW) * NB;       B3_GLDS(slot_, gb_, offv); } \
        else                  { const bf16* gb_ = Pz + (size_t)((2 * (rp_) + (pos_) - 20) * GRIDW) * NB;   B3_GLDS(slot_, gb_, offk); } } while (0)
#define B3_ISSUE2(pos_) do { if ((pos_) < 22) { B3_ISSUE((pos_), rp, ru, (sb + (pos_)) & 7); B3_ISSUE((pos_) + 1, rp, ru, (sb + (pos_) + 1) & 7); } \
        else { B3_ISSUE((pos_) - 22, rpn, run, (sb + (pos_)) & 7); B3_ISSUE((pos_) - 21, rpn, run, (sb + (pos_) + 1) & 7); } } while (0)
#define B3_WAITV(n_) asm volatile("s_waitcnt vmcnt(" #n_ ")" ::: "memory")
#define B3_BAR() do { asm volatile("s_waitcnt lgkmcnt(0)" ::: "memory"); __builtin_amdgcn_s_barrier(); asm volatile("" ::: "memory"); } while (0)
#define B3_POS(p_) { \
                    const LAS unsigned char* slot = RING + ((sb + (p_)) & 7) * 16384; \
                    if ((p_) == 1) { \
                        const LAS unsigned char* qs = RING + ((sb + rsel) & 7) * 16384; const int row = 16 * qb + i16; \
                        _Pragma("unroll") for (int ks = 0; ks < 4; ++ks) qf[ks] = *(const LAS bf16x8*)(qs + row * 256 + (((4 * ks + g16) ^ (row & 15)) << 4)); \
                    } \
                    if ((p_) >= 2 && (p_) < 11) { \
                        const int s = (p_) - 2; \
                        { bf16x8 kf[8]; \
                        _Pragma("unroll") for (int half = 0; half < 2; ++half) { const int row = kc0 + 16 * half + i16; \
                            _Pragma("unroll") for (int ks = 0; ks < 4; ++ks) kf[4 * half + ks] = *(const LAS bf16x8*)(slot + row * 256 + (((4 * ks + g16) ^ (row & 15)) << 4)); } \
                        __builtin_amdgcn_sched_barrier(0);                    \
                        _Pragma("unroll") for (int half = 0; half < 2; ++half) \
                            _Pragma("unroll") for (int ks = 0; ks < 4; ++ks) S[2 * s + half] = __builtin_amdgcn_mfma_f32_16x16x32_bf16(kf[4 * half + ks], qf[ks], S[2 * s + half], 0, 0, 0); } \
                    } \
                    if ((p_) == 10) { \
                        float mx = -__builtin_inff(); \
                        const LAS float* bp0 = RPB + (ru - r + 7) * 31 + coff[0]; const LAS float* bp1 = RPB + (ru - r + 7) * 31 + coff[1]; \
                        const LAS float* bp2 = RPB + (ru - r + 7) * 31 + coff[2]; const LAS float* bp3 = RPB + (ru - r + 7) * 31 + coff[3]; \
                        _Pragma("unroll") for (int s = 0; s < 9; ++s) { const bool rv = (ru + s >= rs) && (ru + s < rs + 8); \
                            float x0 = (in0[0] ? S[2 * s][0] : S[2 * s + 1][0]) + bp0[31 * s], x1 = (in0[1] ? S[2 * s][1] : S[2 * s + 1][1]) + bp1[31 * s]; \
                            float x2 = (in0[2] ? S[2 * s][2] : S[2 * s + 1][2]) + bp2[31 * s], x3 = (in0[3] ? S[2 * s][3] : S[2 * s + 1][3]) + bp3[31 * s]; \
                            if (!rv) { x0 = -__builtin_inff(); x1 = x0; x2 = x0; x3 = x0; } \
                            S[2 * s][0] = x0; S[2 * s][1] = x1; S[2 * s][2] = x2; S[2 * s][3] = x3; mx = fmaxf(fmaxf(mx, x0), fmaxf(fmaxf(x1, x2), x3)); } \
                        mx = fmaxf(mx, shx<16>(mx)); mx = max_x32(mx); \
                        _Pragma("unroll") for (int s = 0; s < 9; ++s) { \
                            const float p0 = __builtin_amdgcn_exp2f(S[2 * s][0] - mx), p1 = __builtin_amdgcn_exp2f(S[2 * s][1] - mx), p2 = __builtin_amdgcn_exp2f(S[2 * s][2] - mx), p3 = __builtin_amdgcn_exp2f(S[2 * s][3] - mx); \
                            l += (p0 + p1) + (p2 + p3); \
                            const unsigned w01 = pg8::cvt_pk_bf16(p0, p1), w23 = pg8::cvt_pk_bf16(p2, p3); \
                            const v4u pw = (v4u){w01 & msk[0], w23 & msk[1], w01 & ~msk[0], w23 & ~msk[1]}; P[s] = __builtin_bit_cast(bf16x8, pw); } \
                        l += shx<16>(l); l = add_x32(l); \
                    } \
                    if ((p_) >= 11 && (p_) < 20) { \
                        const int s = (p_) - 11; \
                        { \
                        const int row = kc0 + 4 * g16 + (i16 >> 2); \
                        const LAS unsigned char* vb = slot + row * 256 + (i16 & 3) * 8; \
                        s16x4 vlo[8], vhi[8]; \
                        _Pragma("unroll") for (int dt = 0; dt < 8; ++dt) { const int gofs = ((dt ^ (row & 7)) << 5); vlo[dt] = tr16(vb + gofs); vhi[dt] = tr16(vb + 16 * 256 + gofs); } \
                        __builtin_amdgcn_sched_barrier(0); \
                        _Pragma("unroll") for (int dt = 0; dt < 8; ++dt) { \
                            const bf16x8 afr = (bf16x8){vlo[dt][0], vlo[dt][1], vlo[dt][2], vlo[dt][3], vhi[dt][0], vhi[dt][1], vhi[dt][2], vhi[dt][3]}; \
                            O[dt] = __builtin_amdgcn_mfma_f32_16x16x32_bf16(afr, P[s], O[dt], 0, 0, 0); } } \
                    } \
                    if ((p_) == 21) { \
                        const LAS unsigned char* zs = RING + ((sb + 20 + rsel) & 7) * 16384; const int row = 16 * qb + i16; \
                        const float il = 32.0f / l;                           \
                        unsigned char* yptr = (unsigned char*)Y + (size_t)(r * GRIDW + c) * E + h * HD + 4 * g16; \
                        _Pragma("unroll") for (int dt = 0; dt < 8; ++dt) { \
                            const u32x2 z2 = *(const LAS u32x2*)(zs + row * 256 + (((2 * dt + (g16 >> 1)) ^ (row & 15)) << 4) + (g16 & 1) * 8); const f32x4 o = O[dt]; \
                            const float y0 = fminf(fmaxf(o.x * il * bflo(z2.x), -448.f), 448.f), y1 = fminf(fmaxf(o.y * il * bfhi(z2.x), -448.f), 448.f); \
                            const float y2 = fminf(fmaxf(o.z * il * bflo(z2.y), -448.f), 448.f), y3 = fminf(fmaxf(o.w * il * bfhi(z2.y), -448.f), 448.f); \
                            *(unsigned*)(yptr + 16 * dt) = pk4_fp8(y0, y1, y2, y3); } \
                    } \
                }
#define B3_PAIR(d_) { if ((d_) < 3 && k > 0) B3_WAITV(16); else B3_WAITV(8); B3_BAR(); B3_ISSUE2(2 * (d_) + 6); B3_POS(2 * (d_)) B3_POS(2 * (d_) + 1) }
            const int nu = (R / 2) / (G >> 3);
            for (int hi = 0; hi < NHEAD / 8; ++hi) {
            const int h = (bx & 7) + 8 * hi;
            const bf16* Pq = PROJ + h * HD; const bf16* Pk = PROJ + E + h * HD; const bf16* Pv = PROJ + 2 * E + h * HD; const bf16* Pz = PROJ + 3 * E + h * HD;
            for (int e = tid; e < 465 + 128; e += NWAVES * 64) { const int idx = e - 64; RPB[idx] = (idx >= 0 && idx < 465) ? args.in[10][(size_t)h * 465 + idx] * 1.4426950409f : 0.f; }
            __syncthreads();
            {
                const int rp0 = bx >> 3, ru0 = min(min(max(2 * rp0 - 4, 0), R - 8), R - 9);
#pragma unroll
                for (int p = 0; p < 6; ++p) B3_ISSUE(p, rp0, ru0, p);
            }
            for (int k = 0; k < nu; ++k) {
                const int rp = (bx >> 3) + (G >> 3) * k, rpn = (k + 1 < nu) ? rp + (G >> 3) : rp;
                const int ru = min(min(max(2 * rp - 4, 0), R - 8), R - 9), run = min(min(max(2 * rpn - 4, 0), R - 8), R - 9);
                const int r = 2 * rp + rsel, rs = min(max(r - 4, 0), R - 8);
                const int sb = 6 * k;
                bf16x8 qf[4]; f32x4 S[18]; bf16x8 P[9]; f32x4 O[8]; float l = 0.f;
#pragma unroll
                for (int t = 0; t < 18; ++t) S[t] = (f32x4){0.f, 0.f, 0.f, 0.f};
#pragma unroll
                for (int dt = 0; dt < 8; ++dt) O[dt] = (f32x4){0.f, 0.f, 0.f, 0.f};
                B3_PAIR(0) B3_PAIR(1) B3_PAIR(2) B3_PAIR(3) B3_PAIR(4) B3_PAIR(5) B3_PAIR(6) B3_PAIR(7) B3_PAIR(8) B3_PAIR(9) B3_PAIR(10)
            }
            B3_WAITV(0); B3_BAR();
            }
#undef B3_PAIR
#undef B3_POS
#undef B3_GLDS
#undef B3_ISSUE
#undef B3_ISSUE2
#undef B3_WAITV
#undef B3_BAR
        }
#endif
        GRID_BAR();

        {
            PHASE_PTRS();
            pg8::Gemm g{Y, WBOUT, M, D, E / 2}; pg8::StaticOrder S; S.init(M, D, G, bx);
            pg8::EpiRes Ep{xo, xo, 1.0f / 1024.0f};
            pg8::gemm_phase<pg8::EpiRes, pg8::StaticOrder, true, true, true, 1, XSYNC_ON>(lds, g, S, Ep, wave, lane, XSYNC_OF(3));
        }
        GRID_BAR();

        { PHASE_PTRS(); for (int row = gw; row < M; row += NGW) rms_row_inplace(xo + (size_t)row * D, args.in[3], lane); }
    }
}

extern "C" void kernel_launch(void* const* d_in, const int* in_sizes, int n_in, void* d_out, int out_size, void* d_ws, size_t ws_size, hipStream_t stream) {
    static int grid = 0;
    if (grid == 0) {
        if (n_in != 12 || out_size != NTOK * D || ws_size < WS_END) { fprintf(stderr, "kernel_launch: unexpected shapes: n_in %d out %d ws %zu (need %zu)\n", n_in, out_size, ws_size, (size_t)WS_END); grid = -1; return; }
        int dev = 0, cus = 0, per_cu = 0;
        if (hipGetDevice(&dev) != hipSuccess || hipDeviceGetAttribute(&cus, hipDeviceAttributeMultiprocessorCount, dev) != hipSuccess) { grid = -1; return; }
        if (hipFuncSetAttribute((const void*)fwd, hipFuncAttributeMaxDynamicSharedMemorySize, LDS_BYTES) != hipSuccess) { fprintf(stderr, "kernel_launch: hipFuncSetAttribute failed\n"); grid = -1; return; }
        if (hipOccupancyMaxActiveBlocksPerMultiprocessor(&per_cu, (const void*)fwd, NWAVES * 64, LDS_BYTES) != hipSuccess || per_cu < 1)
            fprintf(stderr, "kernel_launch: note: occupancy query reports %d workgroups per CU\n", per_cu);
        (void)hipGetLastError();
        grid = cus;
    }
    if (grid < 0) return;
    if (hipMemsetAsync((char*)d_ws + WS_CTL, 0, CTL_ZERO_BYTES, stream) != hipSuccess) { fprintf(stderr, "kernel_launch: hipMemsetAsync failed\n"); return; }
    Args a{};
    for (int i = 0; i < 12; ++i) a.in[i] = (const float*)d_in[i];
    a.out = (float*)d_out; a.ws = (unsigned char*)d_ws;
    hipLaunchKernelGGL(fwd, dim3(grid), dim3(NWAVES * 64), LDS_BYTES, stream, a);
    const hipError_t le = hipPeekAtLastError();
    if (le != hipSuccess) fprintf(stderr, "kernel_launch: launch failed: %s\n", hipGetErrorName(le));
}
```

```cpp
#include <hip/hip_runtime.h>
#include <cstdio>
#include <cstdint>
template <int MASK> __device__ __forceinline__ float shx(float v) {
    static_assert(MASK < 32, "use add_x32 / max_x32 across the halves");
    return __builtin_bit_cast(float, __builtin_amdgcn_ds_swizzle(__builtin_bit_cast(int, v), (MASK << 10) | 0x1f));
}
__device__ __forceinline__ float add_x32(float v) { const unsigned u = __builtin_bit_cast(unsigned, v); auto r = __builtin_amdgcn_permlane32_swap(u, u, false, false); unsigned a = r[0], b = r[1]; asm volatile("" : "+v"(a), "+v"(b)); return __builtin_bit_cast(float, a) + __builtin_bit_cast(float, b); }
__device__ __forceinline__ float max_x32(float v) { const unsigned u = __builtin_bit_cast(unsigned, v); auto r = __builtin_amdgcn_permlane32_swap(u, u, false, false); unsigned a = r[0], b = r[1]; asm volatile("" : "+v"(a), "+v"(b)); return fmaxf(__builtin_bit_cast(float, a), __builtin_bit_cast(float, b)); }
namespace pg8 {
#define PG8_LAS __attribute__((address_space(3)))
typedef unsigned short bf16_t;
typedef short bf16x8 __attribute__((ext_vector_type(8)));
typedef float f32x4 __attribute__((ext_vector_type(4)));
typedef unsigned u32x4 __attribute__((ext_vector_type(4)));
constexpr int BM = 256, BK = 64, HALF = 128, HTB = HALF * BK * 2  , STAGE_BYTES = 8 * HTB, NXCD = 8, WGM = 8;

__host__ __device__ __forceinline__ int lds_byte(int r, int c) { const int st = (r >> 4) * 2 + (c >> 5), rr = r & 15, cc = c & 31, ob = rr * 64 + cc * 2; return st * 1024 + (ob ^ (((ob >> 9) & 1) << 5)); }
__host__ __device__ __forceinline__ void stage_rc(int b, int& R, int& C) { const int st = b / 1024, sb = b % 1024, swz = sb ^ (((sb >> 9) & 1) << 5); R = (st >> 1) * 16 + swz / 64; C = (st & 1) * 32 + (swz % 64) / 2; }
__host__ __device__ __forceinline__ int perm32(int rho) { const int n = rho >> 4, i = rho & 15; return 8 * (i >> 2) + 4 * n + (i & 3); }

struct Unit { int pm, pn; };
struct Gemm { const bf16_t* A; const bf16_t* Bt; int M, N, K; };

struct StaticOrder {
    int nM, nN, nwg, G, c;
    __host__ __device__ void init(int M, int N, int G_, int c_) { nM = M / BM; nN = N / BM; nwg = nM * nN; G = G_; c = c_; }
    __host__ __device__ bool next(int i, Unit& u) const {
        const long L = (long)i * G + c; if (L >= nwg) return false;
        int wgid = (int)L; { const int q = nwg / NXCD, r = nwg % NXCD, xcd = wgid % NXCD, off = wgid / NXCD; wgid = (xcd < r ? xcd * (q + 1) : r * (q + 1) + (xcd - r) * q) + off; }
        const int nig = WGM * nN, gid = wgid / nig, fm = gid * WGM, gsz = (nM - fm) < WGM ? (nM - fm) : WGM;
        u.pm = fm + ((wgid % nig) % gsz); u.pn = (wgid % nig) / gsz; return true;
    }
    __device__ __forceinline__ void a_ready(const Unit&) const {}
    __device__ __forceinline__ void done(const Unit&) const {}
};

__device__ __forceinline__ unsigned cvt_pk_bf16(float lo, float hi) { unsigned r; asm volatile("v_cvt_pk_bf16_f32 %0, %1, %2" : "=v"(r) : "v"(lo), "v"(hi)); return r; }
typedef float f32x2 __attribute__((ext_vector_type(2)));
__device__ __forceinline__ float gelu_tanh(float x) { const float t = x * (1.0f + 0.044715f * x * x); return x * __builtin_amdgcn_rcpf(1.0f + __builtin_amdgcn_exp2f(-2.3022081981f * t)); }
__device__ __forceinline__ float silu_f(float x) { return x * __builtin_amdgcn_rcpf(1.0f + __builtin_amdgcn_exp2f(-1.4426950409f * x)); }

struct EpiAin {
    static constexpr bool PERM = true, AFTER_DRAIN = false, IDEM = true;
    bf16_t* O; float* stats;
    __device__ __forceinline__ void operator()(const f32x4 (&acc)[2][2][4][2], const Unit& u, int wr, int wc, int fr, int fq) const {
        const int reg = u.pn >> 4;
        const int row0 = u.pm * BM + wr * 64 + fr, col0 = u.pn * BM + wc * 32 + 8 * fq;
#pragma unroll
        for (int ai = 0; ai < 2; ++ai)
#pragma unroll
            for (int m = 0; m < 4; ++m) {
                const int row = row0 + ai * HALF + m * 16;
                bf16_t* rowp = O + (size_t)row * 12288 + col0;
                float ss = 0.f;
#pragma unroll
                for (int bj = 0; bj < 2; ++bj) {
                    f32x4 v0 = acc[ai][bj][m][0], v1 = acc[ai][bj][m][1];
                    if (reg == 2) {
#pragma unroll
                        for (int e = 0; e < 4; ++e) { v0[e] = silu_f(v0[e]); v1[e] = silu_f(v1[e]); }
                    } else {
#pragma unroll
                        for (int e = 0; e < 4; ++e) { v0[e] = gelu_tanh(v0[e]); v1[e] = gelu_tanh(v1[e]); }
                    }
                    if (reg == 1) ss += (v0[0] * v0[0] + v0[1] * v0[1]) + (v0[2] * v0[2] + v0[3] * v0[3]) + (v1[0] * v1[0] + v1[1] * v1[1]) + (v1[2] * v1[2] + v1[3] * v1[3]);
                    u32x4 w; w.x = cvt_pk_bf16(v0[0], v0[1]); w.y = cvt_pk_bf16(v0[2], v0[3]); w.z = cvt_pk_bf16(v1[0], v1[1]); w.w = cvt_pk_bf16(v1[2], v1[3]);
                    *(u32x4*)(rowp + bj * HALF) = w;
#if defined(PROBE_STORE2)
                    asm volatile("" ::: "memory"); *(u32x4*)(rowp + bj * HALF) = w;
#endif
                }
                if (reg == 1) { ss += shx<16>(ss); ss = add_x32(ss); if (fq == 0) stats[(size_t)row * 64 + (u.pn - 16) * 4 + wc] = ss; }
            }
    }
};
struct EpiBin {
    static constexpr bool PERM = true, AFTER_DRAIN = false, IDEM = true;
    bf16_t* O; const float* st1; float wsc;
    __device__ __forceinline__ void operator()(const f32x4 (&acc)[2][2][4][2], const Unit& u, int wr, int wc, int fr, int fq) const {
        const int reg = u.pn >> 4;
        const int row0 = u.pm * BM + wr * 64 + fr, col0 = u.pn * BM + wc * 32 + 8 * fq;
#pragma unroll
        for (int ai = 0; ai < 2; ++ai)
#pragma unroll
            for (int m = 0; m < 4; ++m) {
                const int row = row0 + ai * HALF + m * 16;
                bf16_t* rowp = O + (size_t)row * 16384 + col0;
                float rs_;
                { const f32x4 a_ = *(const f32x4*)(st1 + (size_t)row * 32 + 8 * fq), b_ = *(const f32x4*)(st1 + (size_t)row * 32 + 8 * fq + 4);
                  float t_ = ((a_[0] + a_[1]) + (a_[2] + a_[3])) + ((b_[0] + b_[1]) + (b_[2] + b_[3])); t_ += shx<16>(t_); t_ = add_x32(t_);
                  rs_ = (1.0f / sqrtf(t_ * (1.0f / 2048.0f) + 1e-6f)) * wsc; }
#pragma unroll
                for (int bj = 0; bj < 2; ++bj) {
                    f32x4 v0 = acc[ai][bj][m][0], v1 = acc[ai][bj][m][1];
                    { const float sc = (reg == 0) ? 0.12751743082f * rs_ : rs_; v0 = v0 * sc; v1 = v1 * sc; }
                    if (reg == 3) {
#pragma unroll
                        for (int e = 0; e < 4; ++e) { v0[e] = silu_f(v0[e]); v1[e] = silu_f(v1[e]); }
                    }
                    u32x4 w; w.x = cvt_pk_bf16(v0[0], v0[1]); w.y = cvt_pk_bf16(v0[2], v0[3]); w.z = cvt_pk_bf16(v1[0], v1[1]); w.w = cvt_pk_bf16(v1[2], v1[3]);
                    *(u32x4*)(rowp + bj * HALF) = w;
#if defined(PROBE_STORE2)
                    asm volatile("" ::: "memory"); *(u32x4*)(rowp + bj * HALF) = w;
#endif
                }
            }
    }
};
struct EpiRes {
    static constexpr bool PERM = false, AFTER_DRAIN = false, IDEM = false;
    const float* base; float* out; float sc;
    __device__ __forceinline__ void operator()(const f32x4 (&acc)[2][2][4][2], const Unit& u, int wr, int wc, int fr, int fq) const {
        const int row0 = u.pm * BM + wr * 64 + fr, col0 = u.pn * BM + wc * 32 + 4 * fq;
#pragma unroll
        for (int ai = 0; ai < 2; ++ai) {
            f32x4 bv[4][2][2];
#pragma unroll
            for (int m = 0; m < 4; ++m) { const size_t off = (size_t)(row0 + ai * HALF + m * 16) * 2048 + col0;
#pragma unroll
                for (int bj = 0; bj < 2; ++bj)
#pragma unroll
                    for (int n = 0; n < 2; ++n) bv[m][bj][n] = *(const f32x4*)(base + off + bj * HALF + n * 16); }
            __builtin_amdgcn_sched_barrier(0);
#pragma unroll
            for (int m = 0; m < 4; ++m) { const size_t off = (size_t)(row0 + ai * HALF + m * 16) * 2048 + col0;
#pragma unroll
                for (int bj = 0; bj < 2; ++bj)
#pragma unroll
                    for (int n = 0; n < 2; ++n) *(f32x4*)(out + off + bj * HALF + n * 16) = bv[m][bj][n] + acc[ai][bj][m][n] * sc; }
        }
    }
};

struct EpiResN {
    static constexpr bool PERM = true, AFTER_DRAIN = false, IDEM = true;
    const float* base; float* out; unsigned char* xn8; float* st1; const float* g1;
    __device__ __forceinline__ void operator()(const f32x4 (&acc)[2][2][4][2], const Unit& u, int wr, int wc, int fr, int fq) const {
        const int row0 = u.pm * BM + wr * 64 + fr, col0 = u.pn * BM + wc * 32 + 8 * fq;
        f32x4 gv[2][2];
#pragma unroll
        for (int bj = 0; bj < 2; ++bj)
#pragma unroll
            for (int n = 0; n < 2; ++n) gv[bj][n] = *(const f32x4*)(g1 + col0 + bj * HALF + 4 * n);
#pragma unroll
        for (int ai = 0; ai < 2; ++ai) {
            f32x4 bv[4][2][2];
#pragma unroll
            for (int m = 0; m < 4; ++m) { const size_t off = (size_t)(row0 + ai * HALF + m * 16) * 2048 + col0;
#pragma unroll
                for (int bj = 0; bj < 2; ++bj) { bv[m][bj][0] = *(const f32x4*)(base + off + bj * HALF); bv[m][bj][1] = *(const f32x4*)(base + off + bj * HALF + 4); } }
            __builtin_amdgcn_sched_barrier(0);
#pragma unroll
            for (int m = 0; m < 4; ++m) {
                const int row = row0 + ai * HALF + m * 16; const size_t off = (size_t)row * 2048 + col0;
                float ss = 0.f;
#pragma unroll
                for (int bj = 0; bj < 2; ++bj) {
                    const f32x4 x0 = bv[m][bj][0] + acc[ai][bj][m][0], x1 = bv[m][bj][1] + acc[ai][bj][m][1];
                    *(f32x4*)(out + off + bj * HALF) = x0; *(f32x4*)(out + off + bj * HALF + 4) = x1;
                    ss += ((x0[0] * x0[0] + x0[1] * x0[1]) + (x0[2] * x0[2] + x0[3] * x0[3])) + ((x1[0] * x1[0] + x1[1] * x1[1]) + (x1[2] * x1[2] + x1[3] * x1[3]));
                    const f32x4 y0 = x0 * gv[bj][0], y1 = x1 * gv[bj][1];
                    unsigned w0 = (unsigned)__builtin_amdgcn_cvt_pk_fp8_f32(y0[0], y0[1], 0, false); w0 = (unsigned)__builtin_amdgcn_cvt_pk_fp8_f32(y0[2], y0[3], (int)w0, true);
                    unsigned w1 = (unsigned)__builtin_amdgcn_cvt_pk_fp8_f32(y1[0], y1[1], 0, false); w1 = (unsigned)__builtin_amdgcn_cvt_pk_fp8_f32(y1[2], y1[3], (int)w1, true);
                    typedef unsigned u32x2_ __attribute__((ext_vector_type(2)));
                    const u32x2_ ww_ = {w0, w1}; *(u32x2_*)(xn8 + off + bj * HALF) = ww_;
                }
                ss += shx<16>(ss); ss = add_x32(ss);
                if (fq == 0) st1[(size_t)row * 32 + u.pn * 4 + wc] = ss;
            }
        }
    }
};
typedef int i32x4 __attribute__((ext_vector_type(4)));
typedef int i32x8 __attribute__((ext_vector_type(8)));
#ifdef F8_DEBUG_UNSCALED
#define F8_MMA_BODY(acc_, afr_, bfr_) { typedef long i64x2_ __attribute__((ext_vector_type(2))); const i64x2_ a0_ = __builtin_bit_cast(i64x2_, (afr_).lo), a1_ = __builtin_bit_cast(i64x2_, (afr_).hi), b0_ = __builtin_bit_cast(i64x2_, (bfr_).lo), b1_ = __builtin_bit_cast(i64x2_, (bfr_).hi); \
            acc_ = __builtin_amdgcn_mfma_f32_16x16x32_fp8_fp8(b0_.x, a0_.x, acc_, 0, 0, 0); acc_ = __builtin_amdgcn_mfma_f32_16x16x32_fp8_fp8(b0_.y, a0_.y, acc_, 0, 0, 0); \
            acc_ = __builtin_amdgcn_mfma_f32_16x16x32_fp8_fp8(b1_.x, a1_.x, acc_, 0, 0, 0); acc_ = __builtin_amdgcn_mfma_f32_16x16x32_fp8_fp8(b1_.y, a1_.y, acc_, 0, 0, 0); }
#else
#define F8_MMA_BODY(acc_, afr_, bfr_) asm volatile("v_mfma_f32_16x16x128_f8f6f4 %0, %1, %2, %0" : "+v"(acc_) : "v"(bfr_), "v"(afr_));
#endif
struct XSync { unsigned* cnt; volatile PG8_LAS unsigned* ep; unsigned n; };
__device__ __forceinline__ void xsync_wait(const XSync& xs, int lane) {
    if (lane == 0) { const unsigned e = xs.ep[0] + 1u; xs.ep[0] = e; __hip_atomic_fetch_add(xs.cnt, 1u, __ATOMIC_RELAXED, __HIP_MEMORY_SCOPE_AGENT);
        const unsigned target = e * xs.n; unsigned spins = 0;
        while (__hip_atomic_load(xs.cnt, __ATOMIC_RELAXED, __HIP_MEMORY_SCOPE_AGENT) < target && ++spins < 3000u) __builtin_amdgcn_s_sleep(1); }
}
template <bool F8> struct Fr;
template <> struct Fr<false> { bf16x8 k[2]; __device__ __forceinline__ void set(int i, bf16x8 x) { k[i] = x; } };
template <> struct Fr<true>  { i32x8 v;     __device__ __forceinline__ void set(int i, bf16x8 x) { const i32x4 y = __builtin_bit_cast(i32x4, x); if (i == 0) v.lo = y; else v.hi = y; } };
template <class Epi, class Sched, bool ALIGN_EPI = false, bool SP2 = false, bool F8 = false, int KREP = 1, bool XSYNC = false>
__device__ __forceinline__ void gemm_phase(PG8_LAS unsigned char* lds, const Gemm g, const Sched& S, const Epi& E, int wid_in, int lane_in, const XSync xs = XSync{nullptr, nullptr, 0u}) {
    const int wid = wid_in, lane = lane_in, tid = wid * 64 + lane, wr = wid >> 2, wc = wid & 3, fr = lane & 15, fq = lane >> 4;
    const int K = g.K, nt = K / BK;
    unsigned voffA[2], voffB[2];
#pragma unroll
    for (int i = 0; i < 2; ++i) { int R, C; stage_rc(tid * 16 + i * 8192, R, C); const int Rb = Epi::PERM ? ((R & ~31) + perm32(R & 31)) : R;
        voffA[i] = (unsigned)(R * K + C) * 2u; voffB[i] = (unsigned)(Rb * K + C) * 2u; }
    const size_t kstep = (size_t)(BK * 2);
    const size_t hstep = (size_t)HALF * K * 2;
    const size_t tstep = 2 * hstep;
    const unsigned ldsw = (unsigned)wid * 1024u;
    const int aoff = lds_byte(wr * 64 + fr, fq * 8), boff = lds_byte(wc * 32 + fr, fq * 8);
#define PG8_SA(b, h) (((b) * 2 + (h)) * HTB)
#define PG8_SB(b, h) ((4 + (b) * 2 + (h)) * HTB)
#define PG8_STAGE(bufoff, gbase, voff) do { _Pragma("unroll") for (int _i = 0; _i < 2; ++_i) \
        __builtin_amdgcn_global_load_lds((const unsigned*)((const char*)(gbase) + (voff)[_i]), (PG8_LAS unsigned*)(lds + (bufoff) + ldsw + _i * 8192), 16, 0, 0); } while (0)
#define PG8_LDA(dst, b, h) do { _Pragma("unroll") for (int m = 0; m < 4; ++m) _Pragma("unroll") for (int k = 0; k < 2; ++k) dst[m].set(k, *(const PG8_LAS bf16x8*)(lds + PG8_SA(b, h) + aoff + m * 2048 + k * 1024)); } while (0)
#define PG8_LDB(dst, b, h) do { _Pragma("unroll") for (int n = 0; n < 2; ++n) _Pragma("unroll") for (int k = 0; k < 2; ++k) dst[n].set(k, *(const PG8_LAS bf16x8*)(lds + PG8_SB(b, h) + boff + n * 2048 + k * 1024)); } while (0)
#define PG8_MMA(ai, bj, At, Bt) do { __builtin_amdgcn_s_setprio(1); _Pragma("unroll") for (int m = 0; m < 4; ++m) _Pragma("unroll") for (int n = 0; n < 2; ++n) { \
        if constexpr (F8) { F8_MMA_BODY(acc[ai][bj][m][n], At[m].v, Bt[n].v) } \
        else { _Pragma("unroll") for (int k = 0; k < 2; ++k) acc[ai][bj][m][n] = __builtin_amdgcn_mfma_f32_16x16x32_bf16(Bt[n].k[k], At[m].k[k], acc[ai][bj][m][n], 0, 0, 0); } } \
        __builtin_amdgcn_s_setprio(0); } while (0)
#define PG8_WAIT_V(n) asm volatile("s_waitcnt vmcnt(" #n ")" ::: "memory")
#define PG8_WAIT_L(n) asm volatile("s_waitcnt lgkmcnt(" #n ")" ::: "memory")
#define PG8_BAR __builtin_amdgcn_s_barrier()
#define PG8_SCHED __builtin_amdgcn_sched_barrier(0)
#ifdef PG8_STAGGER
    { const int idx_ = (S.c >> 3) & 31, dl_ = ((idx_ & 7) * 4 + (idx_ >> 3)) * PG8_STAGGER;
      for (int i_ = 0; i_ < dl_; ++i_) __builtin_amdgcn_s_sleep(8); }
#endif
    Unit cur, nxt; int ui = 0;
    if (!S.next(0, cur)) return;
    f32x4 acc[2][2][4][2];
#pragma unroll
    for (int a = 0; a < 2; ++a)
#pragma unroll
        for (int b = 0; b < 2; ++b)
#pragma unroll
            for (int m = 0; m < 4; ++m)
#pragma unroll
                for (int n = 0; n < 2; ++n) acc[a][b][m][n] = (f32x4){0.f, 0.f, 0.f, 0.f};
    Fr<F8> At[4], B0[2], B1[2];
#define PG8_F8_SETTLE() do { if constexpr (F8) asm volatile("s_nop 15\n\ts_nop 15" ::: "memory"); } while (0)
    const char* cA = (const char*)g.A + (size_t)cur.pm * tstep; const char* cB = (const char*)g.Bt + (size_t)cur.pn * tstep;
    S.a_ready(cur);
    if constexpr (SP2) {
        PG8_STAGE(PG8_SB(0, 0), cB, voffB); PG8_STAGE(PG8_SB(0, 1), cB + hstep, voffB); PG8_STAGE(PG8_SA(0, 0), cA, voffA); PG8_STAGE(PG8_SA(0, 1), cA + hstep, voffA);
        if (wr == 1) PG8_BAR;
        PG8_WAIT_V(2); PG8_BAR;
        PG8_STAGE(PG8_SB(1, 0), cB + kstep, voffB); PG8_STAGE(PG8_SA(1, 0), cA + kstep, voffA); PG8_STAGE(PG8_SB(1, 1), cB + hstep + kstep, voffB);
        PG8_WAIT_V(6); PG8_BAR;
    } else {
        PG8_STAGE(PG8_SB(0, 0), cB, voffB); PG8_STAGE(PG8_SA(0, 0), cA, voffA); PG8_STAGE(PG8_SB(0, 1), cB + hstep, voffB); PG8_STAGE(PG8_SA(0, 1), cA + hstep, voffA);
        if (wr == 1) PG8_BAR;
        PG8_WAIT_V(4); PG8_BAR;
        PG8_STAGE(PG8_SB(1, 0), cB + kstep, voffB); PG8_STAGE(PG8_SA(1, 0), cA + kstep, voffA); PG8_STAGE(PG8_SB(1, 1), cB + hstep + kstep, voffB);
        PG8_WAIT_V(6); PG8_BAR;
    }
    for (;;) {
        const bool has_next = S.next(ui + 1, nxt);
        const char* nA = has_next ? (const char*)g.A + (size_t)nxt.pm * tstep : cA; const char* nB = has_next ? (const char*)g.Bt + (size_t)nxt.pn * tstep : cB;
        for (int kr_ = 0; kr_ < KREP; ++kr_) {
        const bool final_ = (kr_ == KREP - 1); const char* nA_ = final_ ? nA : cA; const char* nB_ = final_ ? nB : cB;
        for (int t = 0; t < nt; t += 2) {
            const bool last = (t == nt - 2);
            const char* a1 = cA + (size_t)(t + 1) * kstep;
            const char* a2 = last ? nA_ : cA + (size_t)(t + 2) * kstep; const char* b2 = last ? nB_ : cB + (size_t)(t + 2) * kstep;
            const char* a3 = a2 + kstep; const char* b3 = b2 + kstep;
            if (last && has_next) S.a_ready(nxt);
            if constexpr (SP2) {
            PG8_LDB(B0, 0, 0); PG8_LDB(B1, 0, 1); PG8_SCHED; PG8_LDA(At, 0, 0); PG8_STAGE(PG8_SA(1, 1), a1 + hstep, voffA);
            PG8_WAIT_V(8); PG8_WAIT_L(0); PG8_BAR; PG8_MMA(0, 0, At, B0); PG8_MMA(0, 1, At, B1); PG8_BAR; PG8_SCHED;
            PG8_LDA(At, 0, 1); PG8_STAGE(PG8_SB(0, 0), b2, voffB); PG8_STAGE(PG8_SB(0, 1), b2 + hstep, voffB); PG8_STAGE(PG8_SA(0, 0), a2, voffA);
            PG8_WAIT_V(8); PG8_WAIT_L(0); PG8_BAR; PG8_MMA(1, 0, At, B0); PG8_MMA(1, 1, At, B1); PG8_BAR; PG8_SCHED;
            PG8_LDB(B0, 1, 0); PG8_LDB(B1, 1, 1); PG8_SCHED; PG8_LDA(At, 1, 0); PG8_STAGE(PG8_SA(0, 1), a2 + hstep, voffA);
            PG8_WAIT_V(8); PG8_WAIT_L(0); PG8_BAR; PG8_MMA(0, 0, At, B0); PG8_MMA(0, 1, At, B1); PG8_BAR; PG8_SCHED;
            PG8_LDA(At, 1, 1); PG8_STAGE(PG8_SB(1, 0), b3, voffB); PG8_STAGE(PG8_SB(1, 1), b3 + hstep, voffB); PG8_STAGE(PG8_SA(1, 0), a3, voffA);
            PG8_WAIT_V(8); PG8_WAIT_L(0); PG8_BAR; PG8_MMA(1, 0, At, B0); PG8_MMA(1, 1, At, B1); PG8_BAR; PG8_SCHED;
            } else {
            PG8_LDB(B0, 0, 0); PG8_SCHED; PG8_LDA(At, 0, 0); PG8_STAGE(PG8_SA(1, 1), a1 + hstep, voffA);
            PG8_WAIT_L(8); PG8_BAR; PG8_WAIT_L(0); PG8_MMA(0, 0, At, B0); PG8_BAR; PG8_SCHED;
            PG8_LDB(B1, 0, 1); PG8_STAGE(PG8_SB(0, 0), b2, voffB);
            PG8_BAR; PG8_WAIT_L(0); PG8_MMA(0, 1, At, B1); PG8_BAR;
            PG8_LDA(At, 0, 1); PG8_STAGE(PG8_SA(0, 0), a2, voffA);
            PG8_BAR; PG8_WAIT_L(0); PG8_MMA(1, 0, At, B0); PG8_BAR; PG8_SCHED;
            PG8_STAGE(PG8_SB(0, 1), b2 + hstep, voffB);
            PG8_WAIT_V(6); PG8_BAR; PG8_MMA(1, 1, At, B1); PG8_BAR;
            PG8_LDB(B0, 1, 0); PG8_SCHED; PG8_LDA(At, 1, 0); PG8_STAGE(PG8_SA(0, 1), a2 + hstep, voffA);
            PG8_WAIT_L(8); PG8_BAR; PG8_WAIT_L(0); PG8_MMA(0, 0, At, B0); PG8_BAR; PG8_SCHED;
            PG8_LDB(B1, 1, 1); PG8_STAGE(PG8_SB(1, 0), b3, voffB);
            PG8_BAR; PG8_WAIT_L(0); PG8_MMA(0, 1, At, B1); PG8_BAR;
            PG8_LDA(At, 1, 1); PG8_STAGE(PG8_SA(1, 0), a3, voffA);
            PG8_BAR; PG8_WAIT_L(0); PG8_MMA(1, 0, At, B0); PG8_BAR; PG8_SCHED;
            PG8_STAGE(PG8_SB(1, 1), b3 + hstep, voffB);
            PG8_WAIT_V(6); PG8_BAR; PG8_MMA(1, 1, At, B1); PG8_BAR;
            }
        }
        if (!final_) { PG8_F8_SETTLE();
#if defined(PROBE_EPI_IN_KREP)
            if constexpr (Epi::IDEM) { if constexpr (ALIGN_EPI) { if (wr == 0) PG8_BAR; } E(acc, cur, wr, wc, fr, fq); if constexpr (ALIGN_EPI) { if (wr == 1) PG8_BAR; } }
#endif
            _Pragma("unroll") for (int a = 0; a < 2; ++a) _Pragma("unroll") for (int b = 0; b < 2; ++b) _Pragma("unroll") for (int m = 0; m < 4; ++m) _Pragma("unroll") for (int n = 0; n < 2; ++n) acc[a][b][m][n] = (f32x4){0.f, 0.f, 0.f, 0.f}; }
        }
        PG8_F8_SETTLE();
        if constexpr (ALIGN_EPI) { if (wr == 0) PG8_BAR; }
#ifndef PG8_EREP
#define PG8_EREP 1
#endif
        if constexpr (!Epi::AFTER_DRAIN) { E(acc, cur, wr, wc, fr, fq);
            if constexpr (PG8_EREP > 1 && Epi::IDEM) { asm volatile("s_waitcnt vmcnt(0)" ::: "memory"); E(acc, cur, wr, wc, fr, fq); }
            S.done(cur); }
        if (!has_next) break;
#pragma unroll
        for (int a = 0; a < 2; ++a)
#pragma unroll
            for (int b = 0; b < 2; ++b)
#pragma unroll
                for (int m = 0; m < 4; ++m)
#pragma unroll
                    for (int n = 0; n < 2; ++n) acc[a][b][m][n] = (f32x4){0.f, 0.f, 0.f, 0.f};
        cur = nxt; cA = nA; cB = nB; ++ui;
        if constexpr (XSYNC && ALIGN_EPI) { if (wid == 0) xsync_wait(xs, lane); asm volatile("" ::: "memory"); PG8_BAR; }
        if constexpr (ALIGN_EPI) { if (wr == 1) PG8_BAR; }
    }
    PG8_WAIT_V(0);
    if constexpr (!ALIGN_EPI) { if (wr == 0) PG8_BAR; }
    PG8_BAR;
    if constexpr (Epi::AFTER_DRAIN) { E.fused(acc, cur, wr, wc, fr, fq, lds, wid, lane); S.done(cur); }
#undef PG8_SA
#undef PG8_SB
#undef PG8_STAGE
#undef PG8_LDA
#undef PG8_LDB
#undef PG8_MMA
#undef PG8_WAIT_V
#undef PG8_WAIT_L
#undef PG8_BAR
#undef PG8_SCHED
}
}
#define GAS __attribute__((address_space(1)))
#define LAS __attribute__((address_space(3)))
typedef unsigned short bf16;
typedef unsigned v4u __attribute__((ext_vector_type(4)));
typedef float f32x4 __attribute__((ext_vector_type(4)));
typedef short bf16x8 __attribute__((ext_vector_type(8)));
typedef GAS unsigned gu32;
typedef GAS unsigned long long gu64;
#define RLX_AGENT __ATOMIC_RELAXED, __HIP_MEMORY_SCOPE_AGENT
#define LDS_WAIT() asm volatile("s_waitcnt lgkmcnt(0)" ::: "memory")
#define VM_WAIT() asm volatile("s_waitcnt vmcnt(0)" ::: "memory")
__device__ __forceinline__ unsigned long long rt() { return __builtin_amdgcn_s_memrealtime(); }
__device__ __forceinline__ unsigned f2bf(float f) { unsigned u = __builtin_bit_cast(unsigned, f); return (u + 0x7fffu + ((u >> 16) & 1u)) >> 16; }
__device__ __forceinline__ unsigned pk2(float lo, float hi) { return f2bf(lo) | (f2bf(hi) << 16); }
#define XB_TMO      128
#define XB_XCNT(j)  (256  + 64 * (j))
#define XB_XSUB(j)  (1280 + 64 * (j))
#define XB_XGEN(j)  (2304 + 64 * (j))
#define XB_TOP      3328
#define XB_TOPGEN   3392
#define XCD_BAR_WORDS 3456
#define XB_SPIN_CAP (1u << 18)

__device__ __forceinline__ unsigned xb_ld(unsigned* p)              { return __hip_atomic_load(p, __ATOMIC_RELAXED, __HIP_MEMORY_SCOPE_AGENT); }
__device__ __forceinline__ unsigned xb_add(unsigned* p, unsigned v) { return __hip_atomic_fetch_add(p, v, __ATOMIC_RELAXED, __HIP_MEMORY_SCOPE_AGENT); }
__device__ __forceinline__ unsigned xb_xcc_id() { return (unsigned)__builtin_amdgcn_s_getreg((3 << 11) | 20) & 0xFu; }
#define XB_SPIN(cond, bar) do { unsigned _sp = 0; while (cond) { __builtin_amdgcn_s_sleep(1); \
    if ((++_sp & 255u) == 0u) { if (xb_ld(&(bar)[XB_TMO])) break; if (_sp > XB_SPIN_CAP) { atomicAdd(&(bar)[XB_TMO], 1u); break; } } } } while (0)

struct XcdBarrier {
    unsigned* bar; unsigned x;
    volatile LAS unsigned* st;
};

__device__ __forceinline__ XcdBarrier xcd_barrier_post(unsigned* bar, volatile LAS unsigned* st) {
    XcdBarrier b; b.bar = bar; b.x = xb_xcc_id(); b.st = st;
    if (threadIdx.x == 0) (void)xb_add(&bar[XB_XCNT(b.x)], 1u);
    return b;
}
__device__ __forceinline__ void xcd_barrier_complete(unsigned* bar, unsigned x, unsigned& nloc, unsigned& nx) {
    const unsigned G = gridDim.x * gridDim.y * gridDim.z;
    unsigned sum, cnt, mine, sp = 0u;
    for (;;) {
        sum = 0u; cnt = 0u; mine = 0u;
#pragma unroll
        for (unsigned j = 0; j < 16; ++j) { const unsigned c = xb_ld(&bar[XB_XCNT(j)]); sum += c; cnt += (c > 0u) ? 1u : 0u; mine = (j == x) ? c : mine; }
        if (sum == G) break;
        __builtin_amdgcn_s_sleep(1);
        if ((++sp & 255u) == 0u) { if (xb_ld(&bar[XB_TMO])) break; if (sp > XB_SPIN_CAP) { atomicAdd(&bar[XB_TMO], 1u); break; } }
    }
    nloc = mine > 0u ? mine : 1u; nx = cnt > 0u ? cnt : 1u;
}

__device__ __forceinline__ void xcd_barrier(const XcdBarrier& b) {
    asm volatile("s_waitcnt vmcnt(0)" ::: "memory");
    __syncthreads();
    if (threadIdx.x == 0) {
        unsigned* bar = b.bar;
        __builtin_amdgcn_s_waitcnt(0);
        unsigned nloc = b.st[0], nx = b.st[1];
        if (nloc == 0u) { xcd_barrier_complete(bar, b.x, nloc, nx); b.st[0] = nloc; b.st[1] = nx; }
        const unsigned old = xb_add(&bar[XB_XSUB(b.x)], 1u);
        const unsigned gen = old / nloc;
        if (old + 1u == (gen + 1u) * nloc) {
            __builtin_amdgcn_fence(__ATOMIC_RELEASE, "agent");
            asm volatile("s_waitcnt vmcnt(0)" ::: "memory");
            const unsigned og = xb_add(&bar[XB_TOP], 1u);
            const unsigned tg = og / nx;
            if (og + 1u == (tg + 1u) * nx) xb_add(&bar[XB_TOPGEN], 1u);
            else XB_SPIN(xb_ld(&bar[XB_TOPGEN]) == tg, bar);
            __builtin_amdgcn_fence(__ATOMIC_ACQUIRE, "agent");
            xb_add(&bar[XB_XGEN(b.x)], 1u);
            asm volatile("s_waitcnt vmcnt(0)" ::: "memory");
        } else {
            XB_SPIN(xb_ld(&bar[XB_XGEN(b.x)]) == gen, bar);
            __builtin_amdgcn_fence(__ATOMIC_ACQUIRE, "agent");
            asm volatile("s_waitcnt vmcnt(0)" ::: "memory");
        }
    }
    __syncthreads();
}
__device__ __forceinline__ float wave_sum(float v) {
    v += shx<1>(v); v += shx<2>(v); v += shx<4>(v); v += shx<8>(v); v += shx<16>(v); v = add_x32(v);
    return v;
}
__device__ __forceinline__ float fp8rt(float x) { const int p = __builtin_amdgcn_cvt_pk_fp8_f32(x, x, 0, false); return __builtin_amdgcn_cvt_f32_fp8(p, 0); }
template <bool Q8>
__device__ __forceinline__ void p0_transpose_item(const float* W, int K, int N, bf16* WT, int row_off, LAS float* scr, int item, int lane) {
    const int nblk = N / 32, kb = item / nblk, nb = item % nblk, k0 = 64 * kb, n0 = 32 * nb;
    float wv_[32];
#pragma unroll
    for (int i = 0; i < 32; ++i) { const int kk = 2 * i + (lane >> 5); wv_[i] = W[(size_t)(k0 + kk) * N + n0 + (lane & 31)]; }
#pragma unroll
    for (int i = 0; i < 32; ++i) { const int kk = 2 * i + (lane >> 5); float w1_ = wv_[i]; if (Q8) w1_ = fp8rt(w1_ * 32.0f) * 0.03125f; scr[kk * 33 + (lane & 31)] = w1_; }
    LDS_WAIT(); asm volatile("" ::: "memory");
    const int c = lane & 7;
#pragma unroll
    for (int j = 0; j < 4; ++j) { const int n = (lane >> 3) + 8 * j; const LAS float* s = scr + (8 * c) * 33 + n;
        v4u o; o.x = pk2(s[0 * 33], s[1 * 33]); o.y = pk2(s[2 * 33], s[3 * 33]); o.z = pk2(s[4 * 33], s[5 * 33]); o.w = pk2(s[6 * 33], s[7 * 33]);
        *(GAS v4u*)(WT + (size_t)(row_off + n0 + n) * K + k0 + 8 * c) = o; }
    LDS_WAIT(); asm volatile("" ::: "memory");
}

__device__ __forceinline__ unsigned pk4_fp8(float a, float b, float c, float d) { int w = __builtin_amdgcn_cvt_pk_fp8_f32(a, b, 0, false); w = __builtin_amdgcn_cvt_pk_fp8_f32(c, d, w, true); return (unsigned)w; }
__device__ __forceinline__ void p0_transpose_item_f8(const float* W, int K, int N, unsigned char* WT, float wscale, LAS float* scr, int item, int lane) {
    const int nblk = N / 32, kb = item / nblk, nb = item % nblk, k0 = 64 * kb, n0 = 32 * nb;
    float wv_[32];
#pragma unroll
    for (int i = 0; i < 32; ++i) { const int kk = 2 * i + (lane >> 5); wv_[i] = W[(size_t)(k0 + kk) * N + n0 + (lane & 31)]; }
#pragma unroll
    for (int i = 0; i < 32; ++i) { const int kk = 2 * i + (lane >> 5); scr[kk * 33 + (lane & 31)] = wv_[i] * wscale; }
    LDS_WAIT(); asm volatile("" ::: "memory");
    const int n = lane >> 1, hb = lane & 1; const LAS float* s = scr + (32 * hb) * 33 + n;
    v4u o0, o1;
    o0.x = pk4_fp8(s[0 * 33], s[1 * 33], s[2 * 33], s[3 * 33]);     o0.y = pk4_fp8(s[4 * 33], s[5 * 33], s[6 * 33], s[7 * 33]);
    o0.z = pk4_fp8(s[8 * 33], s[9 * 33], s[10 * 33], s[11 * 33]);   o0.w = pk4_fp8(s[12 * 33], s[13 * 33], s[14 * 33], s[15 * 33]);
    o1.x = pk4_fp8(s[16 * 33], s[17 * 33], s[18 * 33], s[19 * 33]); o1.y = pk4_fp8(s[20 * 33], s[21 * 33], s[22 * 33], s[23 * 33]);
    o1.z = pk4_fp8(s[24 * 33], s[25 * 33], s[26 * 33], s[27 * 33]); o1.w = pk4_fp8(s[28 * 33], s[29 * 33], s[30 * 33], s[31 * 33]);
    GAS v4u* dst = (GAS v4u*)(WT + (size_t)(n0 + n) * K + k0 + 32 * hb); dst[0] = o0; dst[1] = o1;
    LDS_WAIT(); asm volatile("" ::: "memory");
}

constexpr int NWAVES = 8;
constexpr int D = 2048, E = 4096, NA = 3 * E, NB = 4 * E, TP = 8192, TS = 16384, NTOK = TP + 2 * TS, MC = 16384;
constexpr int GRIDW = 64, NHEAD = 32, HD = 128;
constexpr float EPS = 1e-6f;
constexpr size_t MiB = 1u << 20;
constexpr size_t WS_CTL = 0, CTL_ZERO_BYTES = 65536;
constexpr size_t WS_WAIN = 1 * MiB;
constexpr size_t WS_WAOUT = 49 * MiB;
constexpr size_t WS_WBIN = 65 * MiB;
constexpr size_t WS_WBOUT = 97 * MiB;
constexpr size_t WS_XN0 = 105 * MiB;
constexpr size_t WS_XN = 265 * MiB;
constexpr size_t WS_STATS = 297 * MiB;
constexpr size_t WS_STATS1 = 301 * MiB;
constexpr size_t WS_Y = 303 * MiB;
constexpr size_t WS_PROJ = 431 * MiB;
constexpr size_t WS_END = 943 * MiB;
constexpr int CW_BAR = 4096;
static_assert((CW_BAR + XCD_BAR_WORDS) * 4 <= (int)CTL_ZERO_BYTES, "CTL words inside the memset region");
constexpr int RING_BYTES = 131072;
constexpr int LDSCTL_OFF = RING_BYTES, MISC_OFF = LDSCTL_OFF + 320;
constexpr int LDS_BYTES = 147456;
static_assert(MISC_OFF + 128 <= LDS_BYTES, "LDS map");

__device__ __forceinline__ float bf2f(unsigned short b) { return __builtin_bit_cast(float, (unsigned)b << 16); }
__device__ __forceinline__ float bflo(unsigned w) { return __builtin_bit_cast(float, w << 16); }
__device__ __forceinline__ float bfhi(unsigned w) { return __builtin_bit_cast(float, w & 0xffff0000u); }
typedef __bf16 bf16x2_t __attribute__((ext_vector_type(2)));
__device__ __forceinline__ float dot2bf(unsigned a, unsigned b, float acc) { return __builtin_amdgcn_fdot2_f32_bf16(__builtin_bit_cast(bf16x2_t, a), __builtin_bit_cast(bf16x2_t, b), acc, false); }

template <bool Q8>
__device__ __forceinline__ void rms_row_to_bf16(const float* xrow, const float* g, bf16* orow, int lane) {
    const f32x4* xr = (const f32x4*)xrow + lane; const f32x4* gr = (const f32x4*)g + lane;
    f32x4 v[8]; float s = 0.f;
#pragma unroll
    for (int j = 0; j < 8; ++j) { v[j] = xr[64 * j]; s += (v[j].x * v[j].x + v[j].y * v[j].y) + (v[j].z * v[j].z + v[j].w * v[j].w); }
    const float inv = 1.0f / sqrtf(wave_sum(s) * (1.f / D) + EPS);
    unsigned long long* o8 = (unsigned long long*)orow + lane;
#pragma unroll
    for (int j = 0; j < 8; ++j) { const f32x4 gg = gr[64 * j]; f32x4 o = (v[j] * inv) * gg; if (Q8) { o.x = fp8rt(o.x); o.y = fp8rt(o.y); o.z = fp8rt(o.z); o.w = fp8rt(o.w); }
        o8[64 * j] = (unsigned long long)pk2(o.x, o.y) | ((unsigned long long)pk2(o.z, o.w) << 32); }
}
__device__ __forceinline__ void rms_row_to_fp8(const float* xrow, const float* g, unsigned char* orow, int lane) {
    const f32x4* xr = (const f32x4*)xrow + lane; const f32x4* gr = (const f32x4*)g + lane;
    f32x4 v[8]; float s = 0.f;
#pragma unroll
    for (int j = 0; j < 8; ++j) { v[j] = xr[64 * j]; s += (v[j].x * v[j].x + v[j].y * v[j].y) + (v[j].z * v[j].z + v[j].w * v[j].w); }
    const float inv = 1.0f / sqrtf(wave_sum(s) * (1.f / D) + EPS);
    unsigned* o4 = (unsigned*)orow + lane;
#pragma unroll
    for (int j = 0; j < 8; ++j) { const f32x4 gg = gr[64 * j]; const f32x4 o = (v[j] * inv) * gg; o4[64 * j] = pk4_fp8(o.x, o.y, o.z, o.w); }
}
__device__ __forceinline__ void rms_row_inplace(float* xrow, const float* g, int lane) {
    f32x4* xr = (f32x4*)xrow + lane; const f32x4* gr = (const f32x4*)g + lane;
    f32x4 v[8]; float s = 0.f;
#pragma unroll
    for (int j = 0; j < 8; ++j) { v[j] = xr[64 * j]; s += (v[j].x * v[j].x + v[j].y * v[j].y) + (v[j].z * v[j].z + v[j].w * v[j].w); }
    const float inv = 1.0f / sqrtf(wave_sum(s) * (1.f / D) + EPS);
#pragma unroll
    for (int j = 0; j < 8; ++j) { const f32x4 gg = gr[64 * j]; xr[64 * j] = (v[j] * inv) * gg; }
}

typedef short s16x4 __attribute__((ext_vector_type(4)));
typedef unsigned u32x2 __attribute__((ext_vector_type(2)));
__device__ __forceinline__ s16x4 tr16(const LAS unsigned char* p) { return __builtin_bit_cast(s16x4, __builtin_amdgcn_ds_read_tr16_b64_v4i16((LAS s16x4*)p)); }
#ifndef USE_F8
#define USE_F8 true
#endif
#ifndef FP8_EMUL
#define FP8_EMUL false
#endif
#ifndef XSYNC_ON
#define XSYNC_ON false
#endif
#ifndef KREP_A2
#define KREP_A2 1
#endif
#ifndef KREP_A4
#define KREP_A4 1
#endif
#ifndef KREP_B2
#define KREP_B2 1
#endif
#ifndef REP_A2
#define REP_A2 1
#endif
#ifndef REP_A4
#define REP_A4 1
#endif
#ifndef REP_B2
#define REP_B2 1
#endif
#ifndef REP_P0
#define REP_P0 1
#endif
#ifndef REP_A3
#define REP_A3 1
#endif
#ifndef REP_B3
#define REP_B3 1
#endif
struct Args { const float* in[12]; float* out; unsigned char* ws; };

__global__ void __launch_bounds__(NWAVES * 64, 2) fwd(Args args) {
    extern __shared__ __attribute__((aligned(16))) unsigned char lds_raw[];
    LAS unsigned char* lds = (LAS unsigned char*)lds_raw;
    volatile LAS unsigned* MISC = (volatile LAS unsigned*)(lds + MISC_OFF);
    const int wave0 = __builtin_amdgcn_readfirstlane((int)threadIdx.x >> 6);
    const int G = gridDim.x; const int bx = blockIdx.x; const int vcu = (G % 8 == 0) ? (bx % 8) * (G / 8) + bx / 8 : bx;
    const int NGW = G * NWAVES;
#define FRESH_S(x) asm volatile("" : "+s"(x))
#define FRESH_V(x) asm volatile("" : "+v"(x))
#define PHASE_PTRS() size_t z_ = 0; FRESH_S(z_); unsigned char* ws = args.ws + z_; int lane; asm volatile("v_mbcnt_lo_u32_b32 %0, -1, 0\n\tv_mbcnt_hi_u32_b32 %0, -1, %0" : "=v"(lane)); int wave = wave0; FRESH_S(wave); const int tid = wave * 64 + lane, gw = vcu * NWAVES + wave; (void)tid; (void)gw; \
    bf16* WAIN = (bf16*)(ws + WS_WAIN); bf16* WAOUT = (bf16*)(ws + WS_WAOUT); bf16* WBIN = (bf16*)(ws + WS_WBIN); bf16* WBOUT = (bf16*)(ws + WS_WBOUT); \
    bf16* XN = (bf16*)(ws + WS_XN); bf16* XN0 = (bf16*)(ws + WS_XN0); float* STATS = (float*)(ws + WS_STATS); float* STATS1 = (float*)(ws + WS_STATS1); bf16* Y = (bf16*)(ws + WS_Y); bf16* PROJ = (bf16*)(ws + WS_PROJ); \
    (void)WAIN; (void)WAOUT; (void)WBIN; (void)WBOUT; (void)XN; (void)XN0; (void)STATS; (void)STATS1; (void)Y; (void)PROJ; (void)lane
#define XSYNC_OF(bank_) pg8::XSync{(unsigned*)(args.ws + WS_CTL) + 8192 + 512 * (bank_) + 64 * (bx & 7), MISC + 16 + (bank_), (unsigned)((G + 7 - (bx & 7)) >> 3)}
#define GRID_BAR() do { XcdBarrier b_ = bar; size_t zb_ = 0; FRESH_S(zb_); b_.bar = bar.bar + zb_; xcd_barrier(b_); } while (0)
    for (int u = threadIdx.x; u < (LDS_BYTES - LDSCTL_OFF) / 4; u += NWAVES * 64) ((LAS unsigned*)(lds + LDSCTL_OFF))[u] = 0u;
    __syncthreads();
    XcdBarrier bar = xcd_barrier_post((unsigned*)(args.ws + WS_CTL) + CW_BAR, MISC + 8);

#ifndef SKIP_P0
    for (int repp_ = 0; repp_ < REP_P0; ++repp_) {
        PHASE_PTRS();
        LAS float* scr = (LAS float*)(lds + wave * 16384);
        constexpr int I_AIN = (D / 64) * (NA / 32), I_AOUT = (E / 64) * (D / 32), I_BIN = (D / 64) * (NB / 32), I_BOUT = (E / 64) * (D / 32);
        constexpr int NITEMS = I_AIN + I_AOUT + I_BIN + I_BOUT;
        for (int it = gw; it < NITEMS; it += NGW) {
            int r = it;
            if (r < I_AIN) { p0_transpose_item<false>(args.in[4], D, NA, WAIN, 0, scr, r, lane); continue; } r -= I_AIN;
            if (r < I_AOUT) { p0_transpose_item<false>(args.in[8], E, D, WAOUT, 0, scr, r, lane); continue; } r -= I_AOUT;
            if (r < I_BIN) { if (USE_F8) p0_transpose_item_f8(args.in[9], D, NB, (unsigned char*)WBIN, 32.0f, scr, r, lane); else p0_transpose_item<false>(args.in[9], D, NB, WBIN, 0, scr, r, lane); continue; } r -= I_BIN;
            p0_transpose_item_f8(args.in[11], E, D, (unsigned char*)WBOUT, 32.0f, scr, r, lane);
        }
        for (int row = gw; row < NTOK; row += NGW) { const float* xr = (row < TP) ? args.in[0] + (size_t)row * D : args.in[1] + (size_t)(row - TP) * D; rms_row_to_bf16<false>(xr, args.in[2], XN0 + (size_t)row * D, lane); }
    }
#endif
    GRID_BAR();

    for (int sc = 0; sc < 3; ++sc) {
        const int M = (sc == 0) ? TP : TS;
        const int r0 = (sc == 0) ? 0 : TP + (sc - 1) * TS;
        const float* xin = (sc == 0) ? args.in[0] : args.in[1] + (size_t)(sc - 1) * TS * D;
        float* xo = args.out + (size_t)r0 * D;

        for (int repg_ = 0; repg_ < REP_A2; ++repg_) {
            PHASE_PTRS();
            pg8::Gemm g{XN0 + (size_t)r0 * D, WAIN, M, NA, D}; pg8::StaticOrder S; S.init(M, NA, G, bx);
            pg8::EpiAin Ep{PROJ, STATS};
            pg8::gemm_phase<pg8::EpiAin, pg8::StaticOrder, true, true, false, KREP_A2, XSYNC_ON>(lds, g, S, Ep, wave, lane, XSYNC_OF(0));
        }
        GRID_BAR();

#ifndef SKIP_A3
        for (int rep_ = 0; rep_ < REP_A3; ++rep_) {
            PHASE_PTRS();
            LAS unsigned char* VT = lds;
            LAS unsigned char* WN = lds + 69632;
            const int grp = bx & 15, cgrp = wave & 3, phalf = wave >> 2;
            {
                const float* Wsg = args.in[6] + (size_t)grp * 16384;
#pragma unroll
                for (int i = 0; i < 8; ++i) {
                    const int id = tid + 512 * i, p = id >> 5, j = id & 31;
                    const f32x4 w = *(const f32x4*)(Wsg + p * 128 + 4 * j);
                    const unsigned lo = pg8::cvt_pk_bf16(w.x, w.y), hi = pg8::cvt_pk_bf16(w.z, w.w);
                    const int j7 = j & 7, gg = j7 & 3, e0 = (j7 >> 2) * 4, ks = j >> 3, pt = p >> 4, lanep = gg * 16 + (p & 15);
                    LAS unsigned* dst = (LAS unsigned*)(WN + ((pt * 4 + ks) * 64 + lanep) * 16 + e0 * 2); dst[0] = lo; dst[1] = hi;
                }
            }
            const int nchunk = M / 128, cstep = G >> 4;
            const int vrow = tid >> 2, vpart = tid & 3;
            const bf16* vsrc = PROJ + (size_t)vrow * NA + E + grp * 256 + vpart * 8; const float* ssrc = STATS + (size_t)vrow * 64 + vpart * 16;
            v4u vv[8]; f32x4 st[4];
#define A3_LOADV(chunk_) do { const size_t rb_ = (size_t)(chunk_) * 128; \
                _Pragma("unroll") for (int i_ = 0; i_ < 8; ++i_) vv[i_] = *(const v4u*)(vsrc + rb_ * NA + 32 * i_); \
                _Pragma("unroll") for (int i_ = 0; i_ < 4; ++i_) st[i_] = *(const f32x4*)(ssrc + rb_ * 64 + 4 * i_); } while (0)
            for (int chunk = bx >> 4; chunk < nchunk; chunk += cstep) {
                const int rowbase = chunk * 128;
                int lc_ = lane; FRESH_V(lc_); const int g16 = lc_ >> 4, i16 = lc_ & 15;
                A3_LOADV(chunk);
                {
                    float s = (((st[0].x + st[0].y) + (st[0].z + st[0].w)) + ((st[1].x + st[1].y) + (st[1].z + st[1].w))) + (((st[2].x + st[2].y) + (st[2].z + st[2].w)) + ((st[3].x + st[3].y) + (st[3].z + st[3].w)));
                    s += shx<1>(s); s += shx<2>(s);
                    const float inv = 1.0f / sqrtf(s * (1.f / E) + EPS);
#pragma unroll
                    for (int i = 0; i < 8; ++i) { v4u w = vv[i];
                        w.x = pg8::cvt_pk_bf16(bflo(w.x) * inv, bfhi(w.x) * inv); w.y = pg8::cvt_pk_bf16(bflo(w.y) * inv, bfhi(w.y) * inv);
                        w.z = pg8::cvt_pk_bf16(bflo(w.z) * inv, bfhi(w.z) * inv); w.w = pg8::cvt_pk_bf16(bflo(w.w) * inv, bfhi(w.w) * inv);
                        *(LAS v4u*)(VT + vrow * 544 + (4 * i + vpart) * 16) = w; }
                }
                __syncthreads();
                uint2 u2[4][4], z2[4][4];
#pragma unroll
                for (int pt = 0; pt < 4; ++pt) { const size_t row = (size_t)(rowbase + (4 * phalf + pt) * 16 + i16);
#pragma unroll
                    for (int ct = 0; ct < 4; ++ct) { const int c = grp * 256 + (4 * cgrp + ct) * 16 + 4 * g16; u2[pt][ct] = *(const uint2*)(PROJ + row * NA + c); z2[pt][ct] = *(const uint2*)(PROJ + row * NA + 2 * E + c); } }
                __builtin_amdgcn_sched_barrier(0);
                f32x4 acc[4][4];
#pragma unroll
                for (int a = 0; a < 4; ++a)
#pragma unroll
                    for (int b = 0; b < 4; ++b) acc[a][b] = (f32x4){0.f, 0.f, 0.f, 0.f};
#pragma unroll
                for (int ks = 0; ks < 4; ++ks) {
                    bf16x8 bfr[4];
#pragma unroll
                    for (int pt = 0; pt < 4; ++pt) bfr[pt] = *(const LAS bf16x8*)(WN + (((4 * phalf + pt) * 4 + ks) * 64 + lc_) * 16);
#pragma unroll
                    for (int ct = 0; ct < 4; ++ct) {
                        const LAS unsigned char* base = VT + (32 * ks + 4 * g16 + (i16 >> 2)) * 544 + ((4 * cgrp + ct) * 16 + 4 * (i16 & 3)) * 2;
                        const s16x4 lo = tr16(base), hi = tr16(base + 16 * 544);
                        const bf16x8 afr = (bf16x8){lo[0], lo[1], lo[2], lo[3], hi[0], hi[1], hi[2], hi[3]};
#pragma unroll
                        for (int pt = 0; pt < 4; ++pt) acc[ct][pt] = __builtin_amdgcn_mfma_f32_16x16x32_bf16(afr, bfr[pt], acc[ct][pt], 0, 0, 0);
                    }
                }
                __syncthreads();
#pragma unroll
                for (int pt = 0; pt < 4; ++pt) {
                    const int p = (4 * phalf + pt) * 16 + i16; const size_t row = (size_t)(rowbase + p); const float bsv = args.in[7][grp * 128 + p];
#pragma unroll
                    for (int ct = 0; ct < 4; ++ct) {
                        const int c = grp * 256 + (4 * cgrp + ct) * 16 + 4 * g16;
                        const f32x4 vg = *(const f32x4*)(args.in[5] + c);
                        const f32x4 a = acc[ct][pt]; const uint2 uu = u2[pt][ct], zz = z2[pt][ct];
                        const float y0 = bflo(uu.x) * (a.x * vg.x + bsv) * bflo(zz.x), y1 = bfhi(uu.x) * (a.y * vg.y + bsv) * bfhi(zz.x);
                        const float y2 = bflo(uu.y) * (a.z * vg.z + bsv) * bflo(zz.y), y3 = bfhi(uu.y) * (a.w * vg.w + bsv) * bfhi(zz.y);
                        uint2 o; o.x = pg8::cvt_pk_bf16(y0, y1); o.y = pg8::cvt_pk_bf16(y2, y3);
                        *(uint2*)(Y + row * E + c) = o;
                    }
                }
            }
#undef A3_LOADV
            __syncthreads();
        }
#endif
        GRID_BAR();

        for (int repg_ = 0; repg_ < REP_A4; ++repg_) {
            PHASE_PTRS();
            pg8::Gemm g{Y, WAOUT, M, D, E}; pg8::StaticOrder S; S.init(M, D, G, bx);
            pg8::EpiResN Ep{xin, xo, (unsigned char*)XN, STATS1, args.in[2] + D};
            pg8::gemm_phase<pg8::EpiResN, pg8::StaticOrder, true, true, false, KREP_A4, XSYNC_ON>(lds, g, S, Ep, wave, lane, XSYNC_OF(1));
        }
        GRID_BAR();

        for (int repg_ = 0; repg_ < REP_B2; ++repg_) {
            PHASE_PTRS();
            pg8::Gemm g{XN, WBIN, M, NB, USE_F8 ? D / 2 : D}; pg8::StaticOrder S; S.init(M, NB, G, bx);
            pg8::EpiBin Ep{PROJ, STATS1, USE_F8 ? 0.03125f : 1.0f};
            pg8::gemm_phase<pg8::EpiBin, pg8::StaticOrder, true, true, USE_F8, KREP_B2, XSYNC_ON>(lds, g, S, Ep, wave, lane, XSYNC_OF(2));
        }
        GRID_BAR();

#ifndef SKIP_B3
        for (int rep_ = 0; rep_ < REP_B3; ++rep_) {
            PHASE_PTRS();
            const int g16 = lane >> 4, i16 = lane & 15;
            const int R = M / GRIDW;
            const int h = bx & 31, rsel = wave >> 2, qb = wave & 3;
            LAS unsigned char* RING = lds;
            LAS float* RPB = (LAS float*)(lds + 132096) + 64;
            for (int e = tid; e < 465 + 128; e += NWAVES * 64) { const int idx = e - 64; RPB[idx] = (idx >= 0 && idx < 465) ? args.in[10][(size_t)h * 465 + idx] * 1.4426950409f : 0.f; }
            __syncthreads();
            const int c = 16 * qb + i16, cs = min(max(c - 8, 0), GRIDW - 16), kc0 = min(max(16 * qb - 8, 0), 32), thr = cs - kc0;
            int coff[4]; unsigned msk[2] = {0u, 0u}; bool in0[4];
#pragma unroll
            for (int e = 0; e < 4; ++e) { in0[e] = (4 * g16 + e >= thr); coff[e] = kc0 + (in0[e] ? 0 : 16) + 4 * g16 + e - c + 15; if (in0[e]) msk[e >> 1] |= (e & 1) ? 0xffff0000u : 0x0000ffffu; }
            const bf16* Pq = PROJ + h * HD; const bf16* Pk = PROJ + E + h * HD; const bf16* Pv = PROJ + 2 * E + h * HD; const bf16* Pz = PROJ + 3 * E + h * HD;
            int offk[2], offv[2];
#pragma unroll
            for (int j = 0; j < 2; ++j) { const int lr = 4 * (8 * j + wave) + (lane >> 4), ch = lane & 15; offk[j] = lr * NB + ((ch ^ (lr & 15)) << 3); offv[j] = lr * NB + ((ch ^ ((lr & 7) << 1)) << 3); }
#define B3_GLDS(slot_, gb_, offs_) do { _Pragma("unroll") for (int j_ = 0; j_ < 2; ++j_) \
        __builtin_amdgcn_global_load_lds((const unsigned*)((gb_) + (offs_)[j_]), (LAS unsigned*)(RING + (slot_) * 16384 + (8 * j_ + wave) * 1024), 16, 0, 0); } while (0)
#define B3_ISSUE(pos_, rp_, ru_, slot_) do { \
        if ((pos_) < 2)       { const bf16* gb_ = Pq + (size_t)((2 * (rp_) + (pos_)) * GRIDW) * NB;        B3_GLDS(slot_, gb_, offk); } \
        else if ((pos_) < 11) { const bf16* gb_ = Pk + (size_t)(((ru_) + (pos_) - 2) * GRIDW) * NB;        B3_GLDS(slot_, gb_, offk); } \
        else if ((pos_) < 20) { const bf16* gb_ = Pv + (size_t)(((ru_) + (pos_) - 11) * GRIDW) * NB;       B3_GLDS(slot_, gb_, offv); } \
        else                  { const bf16* gb_ = Pz + (size_t)((2 * (rp_) + (pos_) - 20) * GRIDW) * NB;   B3_GLDS(slot_, gb_, offk); } } while (0)
#define B3_ISSUE2(pos_) do { if ((pos_) < 22) { B3_ISSUE((pos_), rp, ru, (sb + (pos_)) & 7); B3_ISSUE((pos_) + 1, rp, ru, (sb + (pos_) + 1) & 7); } \
        else { B3_ISSUE((pos_) - 22, rpn, run, (sb + (pos_)) & 7); B3_ISSUE((pos_) - 21, rpn, run, (sb + (pos_) + 1) & 7); } } while (0)
#define B3_WAITV(n_) asm volatile("s_waitcnt vmcnt(" #n_ ")" ::: "memory")
#define B3_BAR() do { asm volatile("s_waitcnt lgkmcnt(0)" ::: "memory"); __builtin_amdgcn_s_barrier(); asm volatile("" ::: "memory"); } while (0)
#define B3_POS(p_) { \
                    const LAS unsigned char* slot = RING + ((sb + (p_)) & 7) * 16384; \
                    if ((p_) == 1) { \
                        const LAS unsigned char* qs = RING + ((sb + rsel) & 7) * 16384; const int row = 16 * qb + i16; \
                        _Pragma("unroll") for (int ks = 0; ks < 4; ++ks) qf[ks] = *(const LAS bf16x8*)(qs + row * 256 + (((4 * ks + g16) ^ (row & 15)) << 4)); \
                    } \
                    if ((p_) >= 2 && (p_) < 11) { \
                        const int s = (p_) - 2; \
                        { bf16x8 kf[8]; \
                        _Pragma("unroll") for (int half = 0; half < 2; ++half) { const int row = kc0 + 16 * half + i16; \
                            _Pragma("unroll") for (int ks = 0; ks < 4; ++ks) kf[4 * half + ks] = *(const LAS bf16x8*)(slot + row * 256 + (((4 * ks + g16) ^ (row & 15)) << 4)); } \
                        __builtin_amdgcn_sched_barrier(0);                    \
                        _Pragma("unroll") for (int half = 0; half < 2; ++half) \
                            _Pragma("unroll") for (int ks = 0; ks < 4; ++ks) S[2 * s + half] = __builtin_amdgcn_mfma_f32_16x16x32_bf16(kf[4 * half + ks], qf[ks], S[2 * s + half], 0, 0, 0); } \
                    } \
                    if ((p_) == 10) { \
                        float mx = -__builtin_inff(); \
                        const LAS float* bp0 = RPB + (ru - r + 7) * 31 + coff[0]; const LAS float* bp1 = RPB + (ru - r + 7) * 31 + coff[1]; \
                        const LAS float* bp2 = RPB + (ru - r + 7) * 31 + coff[2]; const LAS float* bp3 = RPB + (ru - r + 7) * 31 + coff[3]; \
                        _Pragma("unroll") for (int s = 0; s < 9; ++s) { const bool rv = (ru + s >= rs) && (ru + s < rs + 8); \
                            float x0 = (in0[0] ? S[2 * s][0] : S[2 * s + 1][0]) + bp0[31 * s], x1 = (in0[1] ? S[2 * s][1] : S[2 * s + 1][1]) + bp1[31 * s]; \
                            float x2 = (in0[2] ? S[2 * s][2] : S[2 * s + 1][2]) + bp2[31 * s], x3 = (in0[3] ? S[2 * s][3] : S[2 * s + 1][3]) + bp3[31 * s]; \
                            if (!rv) { x0 = -__builtin_inff(); x1 = x0; x2 = x0; x3 = x0; } \
                            S[2 * s][0] = x0; S[2 * s][1] = x1; S[2 * s][2] = x2; S[2 * s][3] = x3; mx = fmaxf(fmaxf(mx, x0), fmaxf(fmaxf(x1, x2), x3)); } \
                        mx = fmaxf(mx, shx<16>(mx)); mx = max_x32(mx); \
                        _Pragma("unroll") for (int s = 0; s < 9; ++s) { \
                            const float p0 = __builtin_amdgcn_exp2f(S[2 * s][0] - mx), p1 = __builtin_amdgcn_exp2f(S[2 * s][1] - mx), p2 = __builtin_amdgcn_exp2f(S[2 * s][2] - mx), p3 = __builtin_amdgcn_exp2f(S[2 * s][3] - mx); \
                            l += (p0 + p1) + (p2 + p3); \
                            const unsigned w01 = pg8::cvt_pk_bf16(p0, p1), w23 = pg8::cvt_pk_bf16(p2, p3); \
                            const v4u pw = (v4u){w01 & msk[0], w23 & msk[1], w01 & ~msk[0], w23 & ~msk[1]}; P[s] = __builtin_bit_cast(bf16x8, pw); } \
                        l += shx<16>(l); l = add_x32(l); \
                    } \
                    if ((p_) >= 11 && (p_) < 20) { \
                        const int s = (p_) - 11; \
                        { \
                        const int row = kc0 + 4 * g16 + (i16 >> 2); \
                        const LAS unsigned char* vb = slot + row * 256 + (i16 & 3) * 8; \
                        s16x4 vlo[8], vhi[8]; \
                        _Pragma("unroll") for (int dt = 0; dt < 8; ++dt) { const int gofs = ((dt ^ (row & 7)) << 5); vlo[dt] = tr16(vb + gofs); vhi[dt] = tr16(vb + 16 * 256 + gofs); } \
                        __builtin_amdgcn_sched_barrier(0); \
                        _Pragma("unroll") for (int dt = 0; dt < 8; ++dt) { \
                            const bf16x8 afr = (bf16x8){vlo[dt][0], vlo[dt][1], vlo[dt][2], vlo[dt][3], vhi[dt][0], vhi[dt][1], vhi[dt][2], vhi[dt][3]}; \
                            O[dt] = __builtin_amdgcn_mfma_f32_16x16x32_bf16(afr, P[s], O[dt], 0, 0, 0); } } \
                    } \
                    if ((p_) == 21) { \
                        const LAS unsigned char* zs = RING + ((sb + 20 + rsel) & 7) * 16384; const int row = 16 * qb + i16; \
                        const float il = 32.0f / l;                           \
                        unsigned char* yptr = (unsigned char*)Y + (size_t)(r * GRIDW + c) * E + h * HD + 4 * g16; \
                        _Pragma("unroll") for (int dt = 0; dt < 8; ++dt) { \
                            const u32x2 z2 = *(const LAS u32x2*)(zs + row * 256 + (((2 * dt + (g16 >> 1)) ^ (row & 15)) << 4) + (g16 & 1) * 8); const f32x4 o = O[dt]; \
                            const float y0 = fminf(fmaxf(o.x * il * bflo(z2.x), -448.f), 448.f), y1 = fminf(fmaxf(o.y * il * bfhi(z2.x), -448.f), 448.f); \
                            const float y2 = fminf(fmaxf(o.z * il * bflo(z2.y), -448.f), 448.f), y3 = fminf(fmaxf(o.w * il * bfhi(z2.y), -448.f), 448.f); \
                            *(unsigned*)(yptr + 16 * dt) = pk4_fp8(y0, y1, y2, y3); } \
                    } \
                }
#define B3_PAIR(d_) { if ((d_) < 3 && k > 0) B3_WAITV(16); else B3_WAITV(8); B3_BAR(); B3_ISSUE2(2 * (d_) + 6); B3_POS(2 * (d_)) B3_POS(2 * (d_) + 1) }
            const int nu = (R / 2) / (G >> 5);
            {
                const int rp0 = bx >> 5, ru0 = min(min(max(2 * rp0 - 4, 0), R - 8), R - 9);
#pragma unroll
                for (int p = 0; p < 6; ++p) B3_ISSUE(p, rp0, ru0, p);
            }
            for (int k = 0; k < nu; ++k) {
                const int rp = (bx >> 5) + (G >> 5) * k, rpn = (k + 1 < nu) ? rp + (G >> 5) : rp;
                const int ru = min(min(max(2 * rp - 4, 0), R - 8), R - 9), run = min(min(max(2 * rpn - 4, 0), R - 8), R - 9);
                const int r = 2 * rp + rsel, rs = min(max(r - 4, 0), R - 8);
                const int sb = 6 * k;
                bf16x8 qf[4]; f32x4 S[18]; bf16x8 P[9]; f32x4 O[8]; float l = 0.f;
#pragma unroll
                for (int t = 0; t < 18; ++t) S[t] = (f32x4){0.f, 0.f, 0.f, 0.f};
#pragma unroll
                for (int dt = 0; dt < 8; ++dt) O[dt] = (f32x4){0.f, 0.f, 0.f, 0.f};
                B3_PAIR(0) B3_PAIR(1) B3_PAIR(2) B3_PAIR(3) B3_PAIR(4) B3_PAIR(5) B3_PAIR(6) B3_PAIR(7) B3_PAIR(8) B3_PAIR(9) B3_PAIR(10)
            }
            B3_WAITV(0); B3_BAR();
#undef B3_PAIR
#undef B3_POS
#undef B3_GLDS
#undef B3_ISSUE
#undef B3_ISSUE2
#undef B3_WAITV
#undef B3_BAR
        }
#endif
        GRID_BAR();

        {
            PHASE_PTRS();
            pg8::Gemm g{Y, WBOUT, M, D, E / 2}; pg8::StaticOrder S; S.init(M, D, G, bx);
            pg8::EpiRes Ep{xo, xo, 1.0f / 1024.0f};
            pg8::gemm_phase<pg8::EpiRes, pg8::StaticOrder, true, true, true, 1, XSYNC_ON>(lds, g, S, Ep, wave, lane, XSYNC_OF(3));
        }
        GRID_BAR();

        { PHASE_PTRS(); for (int row = gw; row < M; row += NGW) rms_row_inplace(xo + (size_t)row * D, args.in[3], lane); }
    }
}

extern "C" void kernel_launch(void* const* d_in, const int* in_sizes, int n_in, void* d_out, int out_size, void* d_ws, size_t ws_size, hipStream_t stream) {
    static int grid = 0;
    if (grid == 0) {
        if (n_in != 12 || out_size != NTOK * D || ws_size < WS_END) { fprintf(stderr, "kernel_launch: unexpected shapes: n_in %d out %d ws %zu (need %zu)\n", n_in, out_size, ws_size, (size_t)WS_END); grid = -1; return; }
        int dev = 0, cus = 0, per_cu = 0;
        if (hipGetDevice(&dev) != hipSuccess || hipDeviceGetAttribute(&cus, hipDeviceAttributeMultiprocessorCount, dev) != hipSuccess) { grid = -1; return; }
        if (hipFuncSetAttribute((const void*)fwd, hipFuncAttributeMaxDynamicSharedMemorySize, LDS_BYTES) != hipSuccess) { fprintf(stderr, "kernel_launch: hipFuncSetAttribute failed\n"); grid = -1; return; }
        if (hipOccupancyMaxActiveBlocksPerMultiprocessor(&per_cu, (const void*)fwd, NWAVES * 64, LDS_BYTES) != hipSuccess || per_cu < 1)
            fprintf(stderr, "kernel_launch: note: occupancy query reports %d workgroups per CU\n", per_cu);
        (void)hipGetLastError();
        grid = cus;
    }
    if (grid < 0) return;
    if (hipMemsetAsync((char*)d_ws + WS_CTL, 0, CTL_ZERO_BYTES, stream) != hipSuccess) { fprintf(stderr, "kernel_launch: hipMemsetAsync failed\n"); return; }
    Args a{};
    for (int i = 0; i < 12; ++i) a.in[i] = (const float*)d_in[i];
    a.out = (float*)d_out; a.ws = (unsigned char*)d_ws;
    hipLaunchKernelGGL(fwd, dim3(grid), dim3(NWAVES * 64), LDS_BYTES, stream, a);
    const hipError_t le = hipPeekAtLastError();
    if (le != hipSuccess) fprintf(stderr, "kernel_launch: launch failed: %s\n", hipGetErrorName(le));
}
```

```cpp
#include <hip/hip_runtime.h>
#include <cstdio>
#include <cstdint>
template <int MASK> __device__ __forceinline__ float shx(float v) {
    static_assert(MASK < 32, "use add_x32 / max_x32 across the halves");
    return __builtin_bit_cast(float, __builtin_amdgcn_ds_swizzle(__builtin_bit_cast(int, v), (MASK << 10) | 0x1f));
}
__device__ __forceinline__ float add_x32(float v) { const unsigned u = __builtin_bit_cast(unsigned, v); auto r = __builtin_amdgcn_permlane32_swap(u, u, false, false); unsigned a = r[0], b = r[1]; asm volatile("" : "+v"(a), "+v"(b)); return __builtin_bit_cast(float, a) + __builtin_bit_cast(float, b); }
__device__ __forceinline__ float max_x32(float v) { const unsigned u = __builtin_bit_cast(unsigned, v); auto r = __builtin_amdgcn_permlane32_swap(u, u, false, false); unsigned a = r[0], b = r[1]; asm volatile("" : "+v"(a), "+v"(b)); return fmaxf(__builtin_bit_cast(float, a), __builtin_bit_cast(float, b)); }
namespace pg8 {
#define PG8_LAS __attribute__((address_space(3)))
typedef unsigned short bf16_t;
typedef short bf16x8 __attribute__((ext_vector_type(8)));
typedef float f32x4 __attribute__((ext_vector_type(4)));
typedef unsigned u32x4 __attribute__((ext_vector_type(4)));
constexpr int BM = 256, BK = 64, HALF = 128, HTB = HALF * BK * 2  , STAGE_BYTES = 8 * HTB, NXCD = 8, WGM = 8;

__host__ __device__ __forceinline__ int lds_byte(int r, int c) { const int st = (r >> 4) * 2 + (c >> 5), rr = r & 15, cc = c & 31, ob = rr * 64 + cc * 2; return st * 1024 + (ob ^ (((ob >> 9) & 1) << 5)); }
__host__ __device__ __forceinline__ void stage_rc(int b, int& R, int& C) { const int st = b / 1024, sb = b % 1024, swz = sb ^ (((sb >> 9) & 1) << 5); R = (st >> 1) * 16 + swz / 64; C = (st & 1) * 32 + (swz % 64) / 2; }
__host__ __device__ __forceinline__ int perm32(int rho) { const int n = rho >> 4, i = rho & 15; return 8 * (i >> 2) + 4 * n + (i & 3); }

struct Unit { int pm, pn; };
struct Gemm { const bf16_t* A; const bf16_t* Bt; int M, N, K; };

struct StaticOrder {
    int nM, nN, nwg, G, c;
    __host__ __device__ void init(int M, int N, int G_, int c_) { nM = M / BM; nN = N / BM; nwg = nM * nN; G = G_; c = c_; }
    __host__ __device__ bool next(int i, Unit& u) const {
        const long L = (long)i * G + c; if (L >= nwg) return false;
        int wgid = (int)L; { const int q = nwg / NXCD, r = nwg % NXCD, xcd = wgid % NXCD, off = wgid / NXCD; wgid = (xcd < r ? xcd * (q + 1) : r * (q + 1) + (xcd - r) * q) + off; }
        const int nig = WGM * nN, gid = wgid / nig, fm = gid * WGM, gsz = (nM - fm) < WGM ? (nM - fm) : WGM;
        u.pm = fm + ((wgid % nig) % gsz); u.pn = (wgid % nig) / gsz; return true;
    }
    __device__ __forceinline__ void a_ready(const Unit&) const {}
    __device__ __forceinline__ void done(const Unit&) const {}
};

__device__ __forceinline__ unsigned cvt_pk_bf16(float lo, float hi) { unsigned r; asm volatile("v_cvt_pk_bf16_f32 %0, %1, %2" : "=v"(r) : "v"(lo), "v"(hi)); return r; }
typedef float f32x2 __attribute__((ext_vector_type(2)));
__device__ __forceinline__ float gelu_tanh(float x) { const float t = x * (1.0f + 0.044715f * x * x); return x * __builtin_amdgcn_rcpf(1.0f + __builtin_amdgcn_exp2f(-2.3022081981f * t)); }
__device__ __forceinline__ float silu_f(float x) { return x * __builtin_amdgcn_rcpf(1.0f + __builtin_amdgcn_exp2f(-1.4426950409f * x)); }

struct EpiAin {
    static constexpr bool PERM = true, AFTER_DRAIN = false, IDEM = true;
    bf16_t* O; float* stats;
    __device__ __forceinline__ void operator()(const f32x4 (&acc)[2][2][4][2], const Unit& u, int wr, int wc, int fr, int fq) const {
        const int reg = u.pn >> 4;
        const int row0 = u.pm * BM + wr * 64 + fr, col0 = u.pn * BM + wc * 32 + 8 * fq;
#pragma unroll
        for (int ai = 0; ai < 2; ++ai)
#pragma unroll
            for (int m = 0; m < 4; ++m) {
                const int row = row0 + ai * HALF + m * 16;
                bf16_t* rowp = O + (size_t)row * 12288 + col0;
                float ss = 0.f;
#pragma unroll
                for (int bj = 0; bj < 2; ++bj) {
                    f32x4 v0 = acc[ai][bj][m][0], v1 = acc[ai][bj][m][1];
                    if (reg == 2) {
#pragma unroll
                        for (int e = 0; e < 4; ++e) { v0[e] = silu_f(v0[e]); v1[e] = silu_f(v1[e]); }
                    } else {
#pragma unroll
                        for (int e = 0; e < 4; ++e) { v0[e] = gelu_tanh(v0[e]); v1[e] = gelu_tanh(v1[e]); }
                    }
                    if (reg == 1) ss += (v0[0] * v0[0] + v0[1] * v0[1]) + (v0[2] * v0[2] + v0[3] * v0[3]) + (v1[0] * v1[0] + v1[1] * v1[1]) + (v1[2] * v1[2] + v1[3] * v1[3]);
                    u32x4 w; w.x = cvt_pk_bf16(v0[0], v0[1]); w.y = cvt_pk_bf16(v0[2], v0[3]); w.z = cvt_pk_bf16(v1[0], v1[1]); w.w = cvt_pk_bf16(v1[2], v1[3]);
                    *(u32x4*)(rowp + bj * HALF) = w;
#if defined(PROBE_STORE2)
                    asm volatile("" ::: "memory"); *(u32x4*)(rowp + bj * HALF) = w;
#endif
                }
                if (reg == 1) { ss += shx<16>(ss); ss = add_x32(ss); if (fq == 0) stats[(size_t)row * 64 + (u.pn - 16) * 4 + wc] = ss; }
            }
    }
};
struct EpiBin {
    static constexpr bool PERM = true, AFTER_DRAIN = false, IDEM = true;
    bf16_t* O; const float* st1; float wsc;
    __device__ __forceinline__ void operator()(const f32x4 (&acc)[2][2][4][2], const Unit& u, int wr, int wc, int fr, int fq) const {
        const int reg = u.pn >> 4;
        const int row0 = u.pm * BM + wr * 64 + fr, col0 = u.pn * BM + wc * 32 + 8 * fq;
#pragma unroll
        for (int ai = 0; ai < 2; ++ai)
#pragma unroll
            for (int m = 0; m < 4; ++m) {
                const int row = row0 + ai * HALF + m * 16;
                bf16_t* rowp = O + (size_t)row * 16384 + col0;
                float rs_;
                { const f32x4 a_ = *(const f32x4*)(st1 + (size_t)row * 32 + 8 * fq), b_ = *(const f32x4*)(st1 + (size_t)row * 32 + 8 * fq + 4);
                  float t_ = ((a_[0] + a_[1]) + (a_[2] + a_[3])) + ((b_[0] + b_[1]) + (b_[2] + b_[3])); t_ += shx<16>(t_); t_ = add_x32(t_);
                  rs_ = (1.0f / sqrtf(t_ * (1.0f / 2048.0f) + 1e-6f)) * wsc; }
#pragma unroll
                for (int bj = 0; bj < 2; ++bj) {
                    f32x4 v0 = acc[ai][bj][m][0], v1 = acc[ai][bj][m][1];
                    { const float sc = (reg == 0) ? 0.12751743082f * rs_ : rs_; v0 = v0 * sc; v1 = v1 * sc; }
                    if (reg == 3) {
#pragma unroll
                        for (int e = 0; e < 4; ++e) { v0[e] = silu_f(v0[e]); v1[e] = silu_f(v1[e]); }
                    }
                    u32x4 w; w.x = cvt_pk_bf16(v0[0], v0[1]); w.y = cvt_pk_bf16(v0[2], v0[3]); w.z = cvt_pk_bf16(v1[0], v1[1]); w.w = cvt_pk_bf16(v1[2], v1[3]);
                    *(u32x4*)(rowp + bj * HALF) = w;
#if defined(PROBE_STORE2)
                    asm volatile("" ::: "memory"); *(u32x4*)(rowp + bj * HALF) = w;
#endif
                }
            }
    }
};
struct EpiRes {
    static constexpr bool PERM = false, AFTER_DRAIN = false, IDEM = false;
    const float* base; float* out; float sc;
    __device__ __forceinline__ void operator()(const f32x4 (&acc)[2][2][4][2], const Unit& u, int wr, int wc, int fr, int fq) const {
        const int row0 = u.pm * BM + wr * 64 + fr, col0 = u.pn * BM + wc * 32 + 4 * fq;
#pragma unroll
        for (int ai = 0; ai < 2; ++ai) {
            f32x4 bv[4][2][2];
#pragma unroll
            for (int m = 0; m < 4; ++m) { const size_t off = (size_t)(row0 + ai * HALF + m * 16) * 2048 + col0;
#pragma unroll
                for (int bj = 0; bj < 2; ++bj)
#pragma unroll
                    for (int n = 0; n < 2; ++n) bv[m][bj][n] = *(const f32x4*)(base + off + bj * HALF + n * 16); }
            __builtin_amdgcn_sched_barrier(0);
#pragma unroll
            for (int m = 0; m < 4; ++m) { const size_t off = (size_t)(row0 + ai * HALF + m * 16) * 2048 + col0;
#pragma unroll
                for (int bj = 0; bj < 2; ++bj)
#pragma unroll
                    for (int n = 0; n < 2; ++n) *(f32x4*)(out + off + bj * HALF + n * 16) = bv[m][bj][n] + acc[ai][bj][m][n] * sc; }
        }
    }
};

struct EpiResN {
    static constexpr bool PERM = true, AFTER_DRAIN = false, IDEM = true;
    const float* base; float* out; unsigned char* xn8; float* st1; const float* g1;
    __device__ __forceinline__ void operator()(const f32x4 (&acc)[2][2][4][2], const Unit& u, int wr, int wc, int fr, int fq) const {
        const int row0 = u.pm * BM + wr * 64 + fr, col0 = u.pn * BM + wc * 32 + 8 * fq;
        f32x4 gv[2][2];
#pragma unroll
        for (int bj = 0; bj < 2; ++bj)
#pragma unroll
            for (int n = 0; n < 2; ++n) gv[bj][n] = *(const f32x4*)(g1 + col0 + bj * HALF + 4 * n);
#pragma unroll
        for (int ai = 0; ai < 2; ++ai) {
            f32x4 bv[4][2][2];
#pragma unroll
            for (int m = 0; m < 4; ++m) { const size_t off = (size_t)(row0 + ai * HALF + m * 16) * 2048 + col0;
#pragma unroll
                for (int bj = 0; bj < 2; ++bj) { bv[m][bj][0] = *(const f32x4*)(base + off + bj * HALF); bv[m][bj][1] = *(const f32x4*)(base + off + bj * HALF + 4); } }
            __builtin_amdgcn_sched_barrier(0);
#pragma unroll
            for (int m = 0; m < 4; ++m) {
                const int row = row0 + ai * HALF + m * 16; const size_t off = (size_t)row * 2048 + col0;
                float ss = 0.f;
#pragma unroll
                for (int bj = 0; bj < 2; ++bj) {
                    const f32x4 x0 = bv[m][bj][0] + acc[ai][bj][m][0], x1 = bv[m][bj][1] + acc[ai][bj][m][1];
                    *(f32x4*)(out + off + bj * HALF) = x0; *(f32x4*)(out + off + bj * HALF + 4) = x1;
                    ss += ((x0[0] * x0[0] + x0[1] * x0[1]) + (x0[2] * x0[2] + x0[3] * x0[3])) + ((x1[0] * x1[0] + x1[1] * x1[1]) + (x1[2] * x1[2] + x1[3] * x1[3]));
                    const f32x4 y0 = x0 * gv[bj][0], y1 = x1 * gv[bj][1];
                    unsigned w0 = (unsigned)__builtin_amdgcn_cvt_pk_fp8_f32(y0[0], y0[1], 0, false); w0 = (unsigned)__builtin_amdgcn_cvt_pk_fp8_f32(y0[2], y0[3], (int)w0, true);
                    unsigned w1 = (unsigned)__builtin_amdgcn_cvt_pk_fp8_f32(y1[0], y1[1], 0, false); w1 = (unsigned)__builtin_amdgcn_cvt_pk_fp8_f32(y1[2], y1[3], (int)w1, true);
                    typedef unsigned u32x2_ __attribute__((ext_vector_type(2)));
                    const u32x2_ ww_ = {w0, w1}; *(u32x2_*)(xn8 + off + bj * HALF) = ww_;
                }
                ss += shx<16>(ss); ss = add_x32(ss);
                if (fq == 0) st1[(size_t)row * 32 + u.pn * 4 + wc] = ss;
            }
        }
    }
};
typedef int i32x4 __attribute__((ext_vector_type(4)));
typedef int i32x8 __attribute__((ext_vector_type(8)));
#ifdef F8_DEBUG_UNSCALED
#define F8_MMA_BODY(acc_, afr_, bfr_) { typedef long i64x2_ __attribute__((ext_vector_type(2))); const i64x2_ a0_ = __builtin_bit_cast(i64x2_, (afr_).lo), a1_ = __builtin_bit_cast(i64x2_, (afr_).hi), b0_ = __builtin_bit_cast(i64x2_, (bfr_).lo), b1_ = __builtin_bit_cast(i64x2_, (bfr_).hi); \
            acc_ = __builtin_amdgcn_mfma_f32_16x16x32_fp8_fp8(b0_.x, a0_.x, acc_, 0, 0, 0); acc_ = __builtin_amdgcn_mfma_f32_16x16x32_fp8_fp8(b0_.y, a0_.y, acc_, 0, 0, 0); \
            acc_ = __builtin_amdgcn_mfma_f32_16x16x32_fp8_fp8(b1_.x, a1_.x, acc_, 0, 0, 0); acc_ = __builtin_amdgcn_mfma_f32_16x16x32_fp8_fp8(b1_.y, a1_.y, acc_, 0, 0, 0); }
#else
#define F8_MMA_BODY(acc_, afr_, bfr_) asm volatile("v_mfma_f32_16x16x128_f8f6f4 %0, %1, %2, %0" : "+v"(acc_) : "v"(bfr_), "v"(afr_));
#endif
struct XSync { unsigned* cnt; volatile PG8_LAS unsigned* ep; unsigned n; };
__device__ __forceinline__ void xsync_wait(const XSync& xs, int lane) {
    if (lane == 0) { const unsigned e = xs.ep[0] + 1u; xs.ep[0] = e; __hip_atomic_fetch_add(xs.cnt, 1u, __ATOMIC_RELAXED, __HIP_MEMORY_SCOPE_AGENT);
        const unsigned target = e * xs.n; unsigned spins = 0;
        while (__hip_atomic_load(xs.cnt, __ATOMIC_RELAXED, __HIP_MEMORY_SCOPE_AGENT) < target && ++spins < 3000u) __builtin_amdgcn_s_sleep(1); }
}
template <bool F8> struct Fr;
template <> struct Fr<false> { bf16x8 k[2]; __device__ __forceinline__ void set(int i, bf16x8 x) { k[i] = x; } };
template <> struct Fr<true>  { i32x8 v;     __device__ __forceinline__ void set(int i, bf16x8 x) { const i32x4 y = __builtin_bit_cast(i32x4, x); if (i == 0) v.lo = y; else v.hi = y; } };
template <class Epi, class Sched, bool ALIGN_EPI = false, bool SP2 = false, bool F8 = false, int KREP = 1, bool XSYNC = false>
__device__ __forceinline__ void gemm_phase(PG8_LAS unsigned char* lds, const Gemm g, const Sched& S, const Epi& E, int wid_in, int lane_in, const XSync xs = XSync{nullptr, nullptr, 0u}) {
    const int wid = wid_in, lane = lane_in, tid = wid * 64 + lane, wr = wid >> 2, wc = wid & 3, fr = lane & 15, fq = lane >> 4;
    const int K = g.K, nt = K / BK;
    unsigned voffA[2], voffB[2];
#pragma unroll
    for (int i = 0; i < 2; ++i) { int R, C; stage_rc(tid * 16 + i * 8192, R, C); const int Rb = Epi::PERM ? ((R & ~31) + perm32(R & 31)) : R;
        voffA[i] = (unsigned)(R * K + C) * 2u; voffB[i] = (unsigned)(Rb * K + C) * 2u; }
    const size_t kstep = (size_t)(BK * 2);
    const size_t hstep = (size_t)HALF * K * 2;
    const size_t tstep = 2 * hstep;
    const unsigned ldsw = (unsigned)wid * 1024u;
    const int aoff = lds_byte(wr * 64 + fr, fq * 8), boff = lds_byte(wc * 32 + fr, fq * 8);
#define PG8_SA(b, h) (((b) * 2 + (h)) * HTB)
#define PG8_SB(b, h) ((4 + (b) * 2 + (h)) * HTB)
#define PG8_STAGE(bufoff, gbase, voff) do { _Pragma("unroll") for (int _i = 0; _i < 2; ++_i) \
        __builtin_amdgcn_global_load_lds((const unsigned*)((const char*)(gbase) + (voff)[_i]), (PG8_LAS unsigned*)(lds + (bufoff) + ldsw + _i * 8192), 16, 0, 0); } while (0)
#define PG8_LDA(dst, b, h) do { _Pragma("unroll") for (int m = 0; m < 4; ++m) _Pragma("unroll") for (int k = 0; k < 2; ++k) dst[m].set(k, *(const PG8_LAS bf16x8*)(lds + PG8_SA(b, h) + aoff + m * 2048 + k * 1024)); } while (0)
#define PG8_LDB(dst, b, h) do { _Pragma("unroll") for (int n = 0; n < 2; ++n) _Pragma("unroll") for (int k = 0; k < 2; ++k) dst[n].set(k, *(const PG8_LAS bf16x8*)(lds + PG8_SB(b, h) + boff + n * 2048 + k * 1024)); } while (0)
#define PG8_MMA(ai, bj, At, Bt) do { __builtin_amdgcn_s_setprio(1); _Pragma("unroll") for (int m = 0; m < 4; ++m) _Pragma("unroll") for (int n = 0; n < 2; ++n) { \
        if constexpr (F8) { F8_MMA_BODY(acc[ai][bj][m][n], At[m].v, Bt[n].v) } \
        else { _Pragma("unroll") for (int k = 0; k < 2; ++k) acc[ai][bj][m][n] = __builtin_amdgcn_mfma_f32_16x16x32_bf16(Bt[n].k[k], At[m].k[k], acc[ai][bj][m][n], 0, 0, 0); } } \
        __builtin_amdgcn_s_setprio(0); } while (0)
#define PG8_WAIT_V(n) asm volatile("s_waitcnt vmcnt(" #n ")" ::: "memory")
#define PG8_WAIT_L(n) asm volatile("s_waitcnt lgkmcnt(" #n ")" ::: "memory")
#define PG8_BAR __builtin_amdgcn_s_barrier()
#define PG8_SCHED __builtin_amdgcn_sched_barrier(0)
#ifdef PG8_STAGGER
    { const int idx_ = (S.c >> 3) & 31, dl_ = ((idx_ & 7) * 4 + (idx_ >> 3)) * PG8_STAGGER;
      for (int i_ = 0; i_ < dl_; ++i_) __builtin_amdgcn_s_sleep(8); }
#endif
    Unit cur, nxt; int ui = 0;
    if (!S.next(0, cur)) return;
    f32x4 acc[2][2][4][2];
#pragma unroll
    for (int a = 0; a < 2; ++a)
#pragma unroll
        for (int b = 0; b < 2; ++b)
#pragma unroll
            for (int m = 0; m < 4; ++m)
#pragma unroll
                for (int n = 0; n < 2; ++n) acc[a][b][m][n] = (f32x4){0.f, 0.f, 0.f, 0.f};
    Fr<F8> At[4], B0[2], B1[2];
#define PG8_F8_SETTLE() do { if constexpr (F8) asm volatile("s_nop 15\n\ts_nop 15" ::: "memory"); } while (0)
    const char* cA = (const char*)g.A + (size_t)cur.pm * tstep; const char* cB = (const char*)g.Bt + (size_t)cur.pn * tstep;
    S.a_ready(cur);
    if constexpr (SP2) {
        PG8_STAGE(PG8_SB(0, 0), cB, voffB); PG8_STAGE(PG8_SB(0, 1), cB + hstep, voffB); PG8_STAGE(PG8_SA(0, 0), cA, voffA); PG8_STAGE(PG8_SA(0, 1), cA + hstep, voffA);
        if (wr == 1) PG8_BAR;
        PG8_WAIT_V(2); PG8_BAR;
        PG8_STAGE(PG8_SB(1, 0), cB + kstep, voffB); PG8_STAGE(PG8_SA(1, 0), cA + kstep, voffA); PG8_STAGE(PG8_SB(1, 1), cB + hstep + kstep, voffB);
        PG8_WAIT_V(6); PG8_BAR;
    } else {
        PG8_STAGE(PG8_SB(0, 0), cB, voffB); PG8_STAGE(PG8_SA(0, 0), cA, voffA); PG8_STAGE(PG8_SB(0, 1), cB + hstep, voffB); PG8_STAGE(PG8_SA(0, 1), cA + hstep, voffA);
        if (wr == 1) PG8_BAR;
        PG8_WAIT_V(4); PG8_BAR;
        PG8_STAGE(PG8_SB(1, 0), cB + kstep, voffB); PG8_STAGE(PG8_SA(1, 0), cA + kstep, voffA); PG8_STAGE(PG8_SB(1, 1), cB + hstep + kstep, voffB);
        PG8_WAIT_V(6); PG8_BAR;
    }
    for (;;) {
        const bool has_next = S.next(ui + 1, nxt);
        const char* nA = has_next ? (const char*)g.A + (size_t)nxt.pm * tstep : cA; const char* nB = has_next ? (const char*)g.Bt + (size_t)nxt.pn * tstep : cB;
        for (int kr_ = 0; kr_ < KREP; ++kr_) {
        const bool final_ = (kr_ == KREP - 1); const char* nA_ = final_ ? nA : cA; const char* nB_ = final_ ? nB : cB;
        for (int t = 0; t < nt; t += 2) {
            const bool last = (t == nt - 2);
            const char* a1 = cA + (size_t)(t + 1) * kstep;
            const char* a2 = last ? nA_ : cA + (size_t)(t + 2) * kstep; const char* b2 = last ? nB_ : cB + (size_t)(t + 2) * kstep;
            const char* a3 = a2 + kstep; const char* b3 = b2 + kstep;
            if (last && has_next) S.a_ready(nxt);
            if constexpr (SP2) {
            PG8_LDB(B0, 0, 0); PG8_LDB(B1, 0, 1); PG8_SCHED; PG8_LDA(At, 0, 0); PG8_STAGE(PG8_SA(1, 1), a1 + hstep, voffA);
            PG8_WAIT_V(8); PG8_WAIT_L(0); PG8_BAR; PG8_MMA(0, 0, At, B0); PG8_MMA(0, 1, At, B1); PG8_BAR; PG8_SCHED;
            PG8_LDA(At, 0, 1); PG8_STAGE(PG8_SB(0, 0), b2, voffB); PG8_STAGE(PG8_SB(0, 1), b2 + hstep, voffB); PG8_STAGE(PG8_SA(0, 0), a2, voffA);
            PG8_WAIT_V(8); PG8_WAIT_L(0); PG8_BAR; PG8_MMA(1, 0, At, B0); PG8_MMA(1, 1, At, B1); PG8_BAR; PG8_SCHED;
            PG8_LDB(B0, 1, 0); PG8_LDB(B1, 1, 1); PG8_SCHED; PG8_LDA(At, 1, 0); PG8_STAGE(PG8_SA(0, 1), a2 + hstep, voffA);
            PG8_WAIT_V(8); PG8_WAIT_L(0); PG8_BAR; PG8_MMA(0, 0, At, B0); PG8_MMA(0, 1, At, B1); PG8_BAR; PG8_SCHED;
            PG8_LDA(At, 1, 1); PG8_STAGE(PG8_SB(1, 0), b3, voffB); PG8_STAGE(PG8_SB(1, 1), b3 + hstep, voffB); PG8_STAGE(PG8_SA(1, 0), a3, voffA);
            PG8_WAIT_V(8); PG8_WAIT_L(0); PG8_BAR; PG8_MMA(1, 0, At, B0); PG8_MMA(1, 1, At, B1); PG8_BAR; PG8_SCHED;
            } else {
            PG8_LDB(B0, 0, 0); PG8_SCHED; PG8_LDA(At, 0, 0); PG8_STAGE(PG8_SA(1, 1), a1 + hstep, voffA);
            PG8_WAIT_L(8); PG8_BAR; PG8_WAIT_L(0); PG8_MMA(0, 0, At, B0); PG8_BAR; PG8_SCHED;
            PG8_LDB(B1, 0, 1); PG8_STAGE(PG8_SB(0, 0), b2, voffB);
            PG8_BAR; PG8_WAIT_L(0); PG8_MMA(0, 1, At, B1); PG8_BAR;
            PG8_LDA(At, 0, 1); PG8_STAGE(PG8_SA(0, 0), a2, voffA);
            PG8_BAR; PG8_WAIT_L(0); PG8_MMA(1, 0, At, B0); PG8_BAR; PG8_SCHED;
            PG8_STAGE(PG8_SB(0, 1), b2 + hstep, voffB);
            PG8_WAIT_V(6); PG8_BAR; PG8_MMA(1, 1, At, B1); PG8_BAR;
            PG8_LDB(B0, 1, 0); PG8_SCHED; PG8_LDA(At, 1, 0); PG8_STAGE(PG8_SA(0, 1), a2 + hstep, voffA);
            PG8_WAIT_L(8); PG8_BAR; PG8_WAIT_L(0); PG8_MMA(0, 0, At, B0); PG8_BAR; PG8_SCHED;
            PG8_LDB(B1, 1, 1); PG8_STAGE(PG8_SB(1, 0), b3, voffB);
            PG8_BAR; PG8_WAIT_L(0); PG8_MMA(0, 1, At, B1); PG8_BAR;
            PG8_LDA(At, 1, 1); PG8_STAGE(PG8_SA(1, 0), a3, voffA);
            PG8_BAR; PG8_WAIT_L(0); PG8_MMA(1, 0, At, B0); PG8_BAR; PG8_SCHED;
            PG8_STAGE(PG8_SB(1, 1), b3 + hstep, voffB);
            PG8_WAIT_V(6); PG8_BAR; PG8_MMA(1, 1, At, B1); PG8_BAR;
            }
        }
        if (!final_) { PG8_F8_SETTLE();
#if defined(PROBE_EPI_IN_KREP)
            if constexpr (Epi::IDEM) { if constexpr (ALIGN_EPI) { if (wr == 0) PG8_BAR; } E(acc, cur, wr, wc, fr, fq); if constexpr (ALIGN_EPI) { if (wr == 1) PG8_BAR; } }
#endif
            _Pragma("unroll") for (int a = 0; a < 2; ++a) _Pragma("unroll") for (int b = 0; b < 2; ++b) _Pragma("unroll") for (int m = 0; m < 4; ++m) _Pragma("unroll") for (int n = 0; n < 2; ++n) acc[a][b][m][n] = (f32x4){0.f, 0.f, 0.f, 0.f}; }
        }
        PG8_F8_SETTLE();
        if constexpr (ALIGN_EPI) { if (wr == 0) PG8_BAR; }
#ifndef PG8_EREP
#define PG8_EREP 1
#endif
        if constexpr (!Epi::AFTER_DRAIN) { E(acc, cur, wr, wc, fr, fq);
            if constexpr (PG8_EREP > 1 && Epi::IDEM) { asm volatile("s_waitcnt vmcnt(0)" ::: "memory"); E(acc, cur, wr, wc, fr, fq); }
            S.done(cur); }
        if (!has_next) break;
#pragma unroll
        for (int a = 0; a < 2; ++a)
#pragma unroll
            for (int b = 0; b < 2; ++b)
#pragma unroll
                for (int m = 0; m < 4; ++m)
#pragma unroll
                    for (int n = 0; n < 2; ++n) acc[a][b][m][n] = (f32x4){0.f, 0.f, 0.f, 0.f};
        cur = nxt; cA = nA; cB = nB; ++ui;
        if constexpr (XSYNC && ALIGN_EPI) { if (wid == 0) xsync_wait(xs, lane); asm volatile("" ::: "memory"); PG8_BAR; }
        if constexpr (ALIGN_EPI) { if (wr == 1) PG8_BAR; }
    }
    PG8_WAIT_V(0);
    if constexpr (!ALIGN_EPI) { if (wr == 0) PG8_BAR; }
    PG8_BAR;
    if constexpr (Epi::AFTER_DRAIN) { E.fused(acc, cur, wr, wc, fr, fq, lds, wid, lane); S.done(cur); }
#undef PG8_SA
#undef PG8_SB
#undef PG8_STAGE
#undef PG8_LDA
#undef PG8_LDB
#undef PG8_MMA
#undef PG8_WAIT_V
#undef PG8_WAIT_L
#undef PG8_BAR
#undef PG8_SCHED
}
}
#define GAS __attribute__((address_space(1)))
#define LAS __attribute__((address_space(3)))
typedef unsigned short bf16;
typedef unsigned v4u __attribute__((ext_vector_type(4)));
typedef float f32x4 __attribute__((ext_vector_type(4)));
typedef short bf16x8 __attribute__((ext_vector_type(8)));
typedef GAS unsigned gu32;
typedef GAS unsigned long long gu64;
#define RLX_AGENT __ATOMIC_RELAXED, __HIP_MEMORY_SCOPE_AGENT
#define LDS_WAIT() asm volatile("s_waitcnt lgkmcnt(0)" ::: "memory")
#define VM_WAIT() asm volatile("s_waitcnt vmcnt(0)" ::: "memory")
__device__ __forceinline__ unsigned long long rt() { return __builtin_amdgcn_s_memrealtime(); }
__device__ __forceinline__ unsigned f2bf(float f) { unsigned u = __builtin_bit_cast(unsigned, f); return (u + 0x7fffu + ((u >> 16) & 1u)) >> 16; }
__device__ __forceinline__ unsigned pk2(float lo, float hi) { return f2bf(lo) | (f2bf(hi) << 16); }
#define XB_TMO      128
#define XB_XCNT(j)  (256  + 64 * (j))
#define XB_XSUB(j)  (1280 + 64 * (j))
#define XB_XGEN(j)  (2304 + 64 * (j))
#define XB_TOP      3328
#define XB_TOPGEN   3392
#define XCD_BAR_WORDS 3456
#define XB_SPIN_CAP (1u << 18)

__device__ __forceinline__ unsigned xb_ld(unsigned* p)              { return __hip_atomic_load(p, __ATOMIC_RELAXED, __HIP_MEMORY_SCOPE_AGENT); }
__device__ __forceinline__ unsigned xb_add(unsigned* p, unsigned v) { return __hip_atomic_fetch_add(p, v, __ATOMIC_RELAXED, __HIP_MEMORY_SCOPE_AGENT); }
__device__ __forceinline__ unsigned xb_xcc_id() { return (unsigned)__builtin_amdgcn_s_getreg((3 << 11) | 20) & 0xFu; }
#define XB_SPIN(cond, bar) do { unsigned _sp = 0; while (cond) { __builtin_amdgcn_s_sleep(1); \
    if ((++_sp & 255u) == 0u) { if (xb_ld(&(bar)[XB_TMO])) break; if (_sp > XB_SPIN_CAP) { atomicAdd(&(bar)[XB_TMO], 1u); break; } } } } while (0)

struct XcdBarrier {
    unsigned* bar; unsigned x;
    volatile LAS unsigned* st;
};

__device__ __forceinline__ XcdBarrier xcd_barrier_post(unsigned* bar, volatile LAS unsigned* st) {
    XcdBarrier b; b.bar = bar; b.x = xb_xcc_id(); b.st = st;
    if (threadIdx.x == 0) (void)xb_add(&bar[XB_XCNT(b.x)], 1u);
    return b;
}
__device__ __forceinline__ void xcd_barrier_complete(unsigned* bar, unsigned x, unsigned& nloc, unsigned& nx) {
    const unsigned G = gridDim.x * gridDim.y * gridDim.z;
    unsigned sum, cnt, mine, sp = 0u;
    for (;;) {
        sum = 0u; cnt = 0u; mine = 0u;
#pragma unroll
        for (unsigned j = 0; j < 16; ++j) { const unsigned c = xb_ld(&bar[XB_XCNT(j)]); sum += c; cnt += (c > 0u) ? 1u : 0u; mine = (j == x) ? c : mine; }
        if (sum == G) break;
        __builtin_amdgcn_s_sleep(1);
        if ((++sp & 255u) == 0u) { if (xb_ld(&bar[XB_TMO])) break; if (sp > XB_SPIN_CAP) { atomicAdd(&bar[XB_TMO], 1u); break; } }
    }
    nloc = mine > 0u ? mine : 1u; nx = cnt > 0u ? cnt : 1u;
}

__device__ __forceinline__ void xcd_barrier(const XcdBarrier& b) {
    asm volatile("s_waitcnt vmcnt(0)" ::: "memory");
    __syncthreads();
    if (threadIdx.x == 0) {
        unsigned* bar = b.bar;
        __builtin_amdgcn_s_waitcnt(0);
        unsigned nloc = b.st[0], nx = b.st[1];
        if (nloc == 0u) { xcd_barrier_complete(bar, b.x, nloc, nx); b.st[0] = nloc; b.st[1] = nx; }
        const unsigned old = xb_add(&bar[XB_XSUB(b.x)], 1u);
        const unsigned gen = old / nloc;
        if (old + 1u == (gen + 1u) * nloc) {
            __builtin_amdgcn_fence(__ATOMIC_RELEASE, "agent");
            asm volatile("s_waitcnt vmcnt(0)" ::: "memory");
            const unsigned og = xb_add(&bar[XB_TOP], 1u);
            const unsigned tg = og / nx;
            if (og + 1u == (tg + 1u) * nx) xb_add(&bar[XB_TOPGEN], 1u);
            else XB_SPIN(xb_ld(&bar[XB_TOPGEN]) == tg, bar);
            __builtin_amdgcn_fence(__ATOMIC_ACQUIRE, "agent");
            xb_add(&bar[XB_XGEN(b.x)], 1u);
            asm volatile("s_waitcnt vmcnt(0)" ::: "memory");
        } else {
            XB_SPIN(xb_ld(&bar[XB_XGEN(b.x)]) == gen, bar);
            __builtin_amdgcn_fence(__ATOMIC_ACQUIRE, "agent");
            asm volatile("s_waitcnt vmcnt(0)" ::: "memory");
        }
    }
    __syncthreads();
}
__device__ __forceinline__ float wave_sum(float v) {
    v += shx<1>(v); v += shx<2>(v); v += shx<4>(v); v += shx<8>(v); v += shx<16>(v); v = add_x32(v);
    return v;
}
__device__ __forceinline__ float fp8rt(float x) { const int p = __builtin_amdgcn_cvt_pk_fp8_f32(x, x, 0, false); return __builtin_amdgcn_cvt_f32_fp8(p, 0); }
template <bool Q8>
__device__ __forceinline__ void p0_transpose_item(const float* W, int K, int N, bf16* WT, int row_off, LAS float* scr, int item, int lane) {
    const int nblk = N / 32, kb = item / nblk, nb = item % nblk, k0 = 64 * kb, n0 = 32 * nb;
    f32x4 wv_[8];
    const int kl_ = lane >> 3, n4_ = (lane & 7) * 4;
#pragma unroll
    for (int i = 0; i < 8; ++i) wv_[i] = *(const f32x4*)(W + (size_t)(k0 + 8 * i + kl_) * N + n0 + n4_);
#pragma unroll
    for (int i = 0; i < 8; ++i) { LAS float* d_ = scr + (8 * i + kl_) * 33 + n4_;
#pragma unroll
        for (int e = 0; e < 4; ++e) { float w1_ = wv_[i][e]; if (Q8) w1_ = fp8rt(w1_ * 32.0f) * 0.03125f; d_[e] = w1_; } }
    LDS_WAIT(); asm volatile("" ::: "memory");
    const int c = lane & 7;
#pragma unroll
    for (int j = 0; j < 4; ++j) { const int n = (lane >> 3) + 8 * j; const LAS float* s = scr + (8 * c) * 33 + n;
        v4u o; o.x = pk2(s[0 * 33], s[1 * 33]); o.y = pk2(s[2 * 33], s[3 * 33]); o.z = pk2(s[4 * 33], s[5 * 33]); o.w = pk2(s[6 * 33], s[7 * 33]);
        *(GAS v4u*)(WT + (size_t)(row_off + n0 + n) * K + k0 + 8 * c) = o; }
    LDS_WAIT(); asm volatile("" ::: "memory");
}

__device__ __forceinline__ unsigned pk4_fp8(float a, float b, float c, float d) { int w = __builtin_amdgcn_cvt_pk_fp8_f32(a, b, 0, false); w = __builtin_amdgcn_cvt_pk_fp8_f32(c, d, w, true); return (unsigned)w; }
__device__ __forceinline__ void p0_transpose_item_f8(const float* W, int K, int N, unsigned char* WT, float wscale, LAS float* scr, int item, int lane) {
    const int nblk = N / 32, kb = item / nblk, nb = item % nblk, k0 = 64 * kb, n0 = 32 * nb;
    f32x4 wv_[8];
    const int kl_ = lane >> 3, n4_ = (lane & 7) * 4;
#pragma unroll
    for (int i = 0; i < 8; ++i) wv_[i] = *(const f32x4*)(W + (size_t)(k0 + 8 * i + kl_) * N + n0 + n4_);
#pragma unroll
    for (int i = 0; i < 8; ++i) { LAS float* d_ = scr + (8 * i + kl_) * 33 + n4_;
#pragma unroll
        for (int e = 0; e < 4; ++e) d_[e] = wv_[i][e] * wscale; }
    LDS_WAIT(); asm volatile("" ::: "memory");
    const int n = lane >> 1, hb = lane & 1; const LAS float* s = scr + (32 * hb) * 33 + n;
    v4u o0, o1;
    o0.x = pk4_fp8(s[0 * 33], s[1 * 33], s[2 * 33], s[3 * 33]);     o0.y = pk4_fp8(s[4 * 33], s[5 * 33], s[6 * 33], s[7 * 33]);
    o0.z = pk4_fp8(s[8 * 33], s[9 * 33], s[10 * 33], s[11 * 33]);   o0.w = pk4_fp8(s[12 * 33], s[13 * 33], s[14 * 33], s[15 * 33]);
    o1.x = pk4_fp8(s[16 * 33], s[17 * 33], s[18 * 33], s[19 * 33]); o1.y = pk4_fp8(s[20 * 33], s[21 * 33], s[22 * 33], s[23 * 33]);
    o1.z = pk4_fp8(s[24 * 33], s[25 * 33], s[26 * 33], s[27 * 33]); o1.w = pk4_fp8(s[28 * 33], s[29 * 33], s[30 * 33], s[31 * 33]);
    GAS v4u* dst = (GAS v4u*)(WT + (size_t)(n0 + n) * K + k0 + 32 * hb); dst[0] = o0; dst[1] = o1;
    LDS_WAIT(); asm volatile("" ::: "memory");
}

constexpr int NWAVES = 8;
constexpr int D = 2048, E = 4096, NA = 3 * E, NB = 4 * E, TP = 8192, TS = 16384, NTOK = TP + 2 * TS, MC = 16384;
constexpr int GRIDW = 64, NHEAD = 32, HD = 128;
constexpr float EPS = 1e-6f;
constexpr size_t MiB = 1u << 20;
constexpr size_t WS_CTL = 0, CTL_ZERO_BYTES = 65536;
constexpr size_t WS_WAIN = 1 * MiB;
constexpr size_t WS_WAOUT = 49 * MiB;
constexpr size_t WS_WBIN = 65 * MiB;
constexpr size_t WS_WBOUT = 97 * MiB;
constexpr size_t WS_XN0 = 105 * MiB;
constexpr size_t WS_XN = 265 * MiB;
constexpr size_t WS_STATS = 297 * MiB;
constexpr size_t WS_STATS1 = 301 * MiB;
constexpr size_t WS_Y = 303 * MiB;
constexpr size_t WS_PROJ = 431 * MiB;
constexpr size_t WS_END = 943 * MiB;
constexpr int CW_BAR = 4096;
static_assert((CW_BAR + XCD_BAR_WORDS) * 4 <= (int)CTL_ZERO_BYTES, "CTL words inside the memset region");
constexpr int RING_BYTES = 131072;
constexpr int LDSCTL_OFF = RING_BYTES, MISC_OFF = LDSCTL_OFF + 320;
constexpr int LDS_BYTES = 147456;
static_assert(MISC_OFF + 128 <= LDS_BYTES, "LDS map");

__device__ __forceinline__ float bf2f(unsigned short b) { return __builtin_bit_cast(float, (unsigned)b << 16); }
__device__ __forceinline__ float bflo(unsigned w) { return __builtin_bit_cast(float, w << 16); }
__device__ __forceinline__ float bfhi(unsigned w) { return __builtin_bit_cast(float, w & 0xffff0000u); }
typedef __bf16 bf16x2_t __attribute__((ext_vector_type(2)));
__device__ __forceinline__ float dot2bf(unsigned a, unsigned b, float acc) { return __builtin_amdgcn_fdot2_f32_bf16(__builtin_bit_cast(bf16x2_t, a), __builtin_bit_cast(bf16x2_t, b), acc, false); }

template <bool Q8>
__device__ __forceinline__ void rms_row_to_bf16(const float* xrow, const float* g, bf16* orow, int lane) {
    const f32x4* xr = (const f32x4*)xrow + lane; const f32x4* gr = (const f32x4*)g + lane;
    f32x4 v[8]; float s = 0.f;
#pragma unroll
    for (int j = 0; j < 8; ++j) { v[j] = xr[64 * j]; s += (v[j].x * v[j].x + v[j].y * v[j].y) + (v[j].z * v[j].z + v[j].w * v[j].w); }
    const float inv = 1.0f / sqrtf(wave_sum(s) * (1.f / D) + EPS);
    unsigned long long* o8 = (unsigned long long*)orow + lane;
#pragma unroll
    for (int j = 0; j < 8; ++j) { const f32x4 gg = gr[64 * j]; f32x4 o = (v[j] * inv) * gg; if (Q8) { o.x = fp8rt(o.x); o.y = fp8rt(o.y); o.z = fp8rt(o.z); o.w = fp8rt(o.w); }
        o8[64 * j] = (unsigned long long)pk2(o.x, o.y) | ((unsigned long long)pk2(o.z, o.w) << 32); }
}
__device__ __forceinline__ void rms_row_to_fp8(const float* xrow, const float* g, unsigned char* orow, int lane) {
    const f32x4* xr = (const f32x4*)xrow + lane; const f32x4* gr = (const f32x4*)g + lane;
    f32x4 v[8]; float s = 0.f;
#pragma unroll
    for (int j = 0; j < 8; ++j) { v[j] = xr[64 * j]; s += (v[j].x * v[j].x + v[j].y * v[j].y) + (v[j].z * v[j].z + v[j].w * v[j].w); }
    const float inv = 1.0f / sqrtf(wave_sum(s) * (1.f / D) + EPS);
    unsigned* o4 = (unsigned*)orow + lane;
#pragma unroll
    for (int j = 0; j < 8; ++j) { const f32x4 gg = gr[64 * j]; const f32x4 o = (v[j] * inv) * gg; o4[64 * j] = pk4_fp8(o.x, o.y, o.z, o.w); }
}
__device__ __forceinline__ void rms_row_inplace(float* xrow, const float* g, int lane) {
    f32x4* xr = (f32x4*)xrow + lane; const f32x4* gr = (const f32x4*)g + lane;
    f32x4 v[8]; float s = 0.f;
#pragma unroll
    for (int j = 0; j < 8; ++j) { v[j] = xr[64 * j]; s += (v[j].x * v[j].x + v[j].y * v[j].y) + (v[j].z * v[j].z + v[j].w * v[j].w); }
    const float inv = 1.0f / sqrtf(wave_sum(s) * (1.f / D) + EPS);
#pragma unroll
    for (int j = 0; j < 8; ++j) { const f32x4 gg = gr[64 * j]; xr[64 * j] = (v[j] * inv) * gg; }
}

typedef short s16x4 __attribute__((ext_vector_type(4)));
typedef unsigned u32x2 __attribute__((ext_vector_type(2)));
__device__ __forceinline__ s16x4 tr16(const LAS unsigned char* p) { return __builtin_bit_cast(s16x4, __builtin_amdgcn_ds_read_tr16_b64_v4i16((LAS s16x4*)p)); }
#ifndef USE_F8
#define USE_F8 true
#endif
#ifndef FP8_EMUL
#define FP8_EMUL false
#endif
#ifndef XSYNC_ON
#define XSYNC_ON false
#endif
#ifndef KREP_A2
#define KREP_A2 1
#endif
#ifndef KREP_A4
#define KREP_A4 1
#endif
#ifndef KREP_B2
#define KREP_B2 1
#endif
#ifndef REP_A2
#define REP_A2 1
#endif
#ifndef REP_A4
#define REP_A4 1
#endif
#ifndef REP_B2
#define REP_B2 1
#endif
#ifndef REP_P0
#define REP_P0 1
#endif
#ifndef REP_A3
#define REP_A3 1
#endif
#ifndef REP_B3
#define REP_B3 1
#endif
struct Args { const float* in[12]; float* out; unsigned char* ws; };

__global__ void __launch_bounds__(NWAVES * 64, 2) fwd(Args args) {
    extern __shared__ __attribute__((aligned(16))) unsigned char lds_raw[];
    LAS unsigned char* lds = (LAS unsigned char*)lds_raw;
    volatile LAS unsigned* MISC = (volatile LAS unsigned*)(lds + MISC_OFF);
    const int wave0 = __builtin_amdgcn_readfirstlane((int)threadIdx.x >> 6);
    const int G = gridDim.x; const int bx = blockIdx.x; const int vcu = (G % 8 == 0) ? (bx % 8) * (G / 8) + bx / 8 : bx;
    const int NGW = G * NWAVES;
#define FRESH_S(x) asm volatile("" : "+s"(x))
#define FRESH_V(x) asm volatile("" : "+v"(x))
#define PHASE_PTRS() size_t z_ = 0; FRESH_S(z_); unsigned char* ws = args.ws + z_; int lane; asm volatile("v_mbcnt_lo_u32_b32 %0, -1, 0\n\tv_mbcnt_hi_u32_b32 %0, -1, %0" : "=v"(lane)); int wave = wave0; FRESH_S(wave); const int tid = wave * 64 + lane, gw = vcu * NWAVES + wave; (void)tid; (void)gw; \
    bf16* WAIN = (bf16*)(ws + WS_WAIN); bf16* WAOUT = (bf16*)(ws + WS_WAOUT); bf16* WBIN = (bf16*)(ws + WS_WBIN); bf16* WBOUT = (bf16*)(ws + WS_WBOUT); \
    bf16* XN = (bf16*)(ws + WS_XN); bf16* XN0 = (bf16*)(ws + WS_XN0); float* STATS = (float*)(ws + WS_STATS); float* STATS1 = (float*)(ws + WS_STATS1); bf16* Y = (bf16*)(ws + WS_Y); bf16* PROJ = (bf16*)(ws + WS_PROJ); \
    (void)WAIN; (void)WAOUT; (void)WBIN; (void)WBOUT; (void)XN; (void)XN0; (void)STATS; (void)STATS1; (void)Y; (void)PROJ; (void)lane
#define XSYNC_OF(bank_) pg8::XSync{(unsigned*)(args.ws + WS_CTL) + 8192 + 512 * (bank_) + 64 * (bx & 7), MISC + 16 + (bank_), (unsigned)((G + 7 - (bx & 7)) >> 3)}
#define GRID_BAR() do { XcdBarrier b_ = bar; size_t zb_ = 0; FRESH_S(zb_); b_.bar = bar.bar + zb_; xcd_barrier(b_); } while (0)
    for (int u = threadIdx.x; u < (LDS_BYTES - LDSCTL_OFF) / 4; u += NWAVES * 64) ((LAS unsigned*)(lds + LDSCTL_OFF))[u] = 0u;
    __syncthreads();
    XcdBarrier bar = xcd_barrier_post((unsigned*)(args.ws + WS_CTL) + CW_BAR, MISC + 8);

#ifndef SKIP_P0
    for (int repp_ = 0; repp_ < REP_P0; ++repp_) {
        PHASE_PTRS();
        LAS float* scr = (LAS float*)(lds + wave * 16384);
        constexpr int I_AIN = (D / 64) * (NA / 32), I_AOUT = (E / 64) * (D / 32), I_BIN = (D / 64) * (NB / 32), I_BOUT = (E / 64) * (D / 32);
        constexpr int NITEMS = I_AIN + I_AOUT + I_BIN + I_BOUT;
        for (int it = gw; it < NITEMS; it += NGW) {
            int r = it;
            if (r < I_AIN) { p0_transpose_item<false>(args.in[4], D, NA, WAIN, 0, scr, r, lane); continue; } r -= I_AIN;
            if (r < I_AOUT) { p0_transpose_item<false>(args.in[8], E, D, WAOUT, 0, scr, r, lane); continue; } r -= I_AOUT;
            if (r < I_BIN) { if (USE_F8) p0_transpose_item_f8(args.in[9], D, NB, (unsigned char*)WBIN, 32.0f, scr, r, lane); else p0_transpose_item<false>(args.in[9], D, NB, WBIN, 0, scr, r, lane); continue; } r -= I_BIN;
            p0_transpose_item_f8(args.in[11], E, D, (unsigned char*)WBOUT, 32.0f, scr, r, lane);
        }
        for (int row = gw; row < NTOK; row += NGW) { const float* xr = (row < TP) ? args.in[0] + (size_t)row * D : args.in[1] + (size_t)(row - TP) * D; rms_row_to_bf16<false>(xr, args.in[2], XN0 + (size_t)row * D, lane); }
    }
#endif
    GRID_BAR();

    for (int sc = 0; sc < 3; ++sc) {
        const int M = (sc == 0) ? TP : TS;
        const int r0 = (sc == 0) ? 0 : TP + (sc - 1) * TS;
        const float* xin = (sc == 0) ? args.in[0] : args.in[1] + (size_t)(sc - 1) * TS * D;
        float* xo = args.out + (size_t)r0 * D;

        for (int repg_ = 0; repg_ < REP_A2; ++repg_) {
            PHASE_PTRS();
            pg8::Gemm g{XN0 + (size_t)r0 * D, WAIN, M, NA, D}; pg8::StaticOrder S; S.init(M, NA, G, bx);
            pg8::EpiAin Ep{PROJ, STATS};
            pg8::gemm_phase<pg8::EpiAin, pg8::StaticOrder, true, true, false, KREP_A2, XSYNC_ON>(lds, g, S, Ep, wave, lane, XSYNC_OF(0));
        }
        GRID_BAR();

#ifndef SKIP_A3
        for (int rep_ = 0; rep_ < REP_A3; ++rep_) {
            PHASE_PTRS();
            LAS unsigned char* VT = lds;
            LAS unsigned char* WN = lds + 69632;
            const int grp = bx & 15, cgrp = wave & 3, phalf = wave >> 2;
            {
                const float* Wsg = args.in[6] + (size_t)grp * 16384;
#pragma unroll
                for (int i = 0; i < 8; ++i) {
                    const int id = tid + 512 * i, p = id >> 5, j = id & 31;
                    const f32x4 w = *(const f32x4*)(Wsg + p * 128 + 4 * j);
                    const unsigned lo = pg8::cvt_pk_bf16(w.x, w.y), hi = pg8::cvt_pk_bf16(w.z, w.w);
                    const int j7 = j & 7, gg = j7 & 3, e0 = (j7 >> 2) * 4, ks = j >> 3, pt = p >> 4, lanep = gg * 16 + (p & 15);
                    LAS unsigned* dst = (LAS unsigned*)(WN + ((pt * 4 + ks) * 64 + lanep) * 16 + e0 * 2); dst[0] = lo; dst[1] = hi;
                }
            }
            const int nchunk = M / 128, cstep = G >> 4;
            const int vrow = tid >> 2, vpart = tid & 3;
            const bf16* vsrc = PROJ + (size_t)vrow * NA + E + grp * 256 + vpart * 8; const float* ssrc = STATS + (size_t)vrow * 64 + vpart * 16;
            v4u vv[8]; f32x4 st[4];
#define A3_LOADV(chunk_) do { const size_t rb_ = (size_t)(chunk_) * 128; \
                _Pragma("unroll") for (int i_ = 0; i_ < 8; ++i_) vv[i_] = *(const v4u*)(vsrc + rb_ * NA + 32 * i_); \
                _Pragma("unroll") for (int i_ = 0; i_ < 4; ++i_) st[i_] = *(const f32x4*)(ssrc + rb_ * 64 + 4 * i_); } while (0)
            for (int chunk = bx >> 4; chunk < nchunk; chunk += cstep) {
                const int rowbase = chunk * 128;
                int lc_ = lane; FRESH_V(lc_); const int g16 = lc_ >> 4, i16 = lc_ & 15;
                A3_LOADV(chunk);
                {
                    float s = (((st[0].x + st[0].y) + (st[0].z + st[0].w)) + ((st[1].x + st[1].y) + (st[1].z + st[1].w))) + (((st[2].x + st[2].y) + (st[2].z + st[2].w)) + ((st[3].x + st[3].y) + (st[3].z + st[3].w)));
                    s += shx<1>(s); s += shx<2>(s);
                    const float inv = 1.0f / sqrtf(s * (1.f / E) + EPS);
#pragma unroll
                    for (int i = 0; i < 8; ++i) { v4u w = vv[i];
                        w.x = pg8::cvt_pk_bf16(bflo(w.x) * inv, bfhi(w.x) * inv); w.y = pg8::cvt_pk_bf16(bflo(w.y) * inv, bfhi(w.y) * inv);
                        w.z = pg8::cvt_pk_bf16(bflo(w.z) * inv, bfhi(w.z) * inv); w.w = pg8::cvt_pk_bf16(bflo(w.w) * inv, bfhi(w.w) * inv);
                        *(LAS v4u*)(VT + vrow * 544 + (4 * i + vpart) * 16) = w; }
                }
                __syncthreads();
                uint2 u2[4][4], z2[4][4];
#pragma unroll
                for (int pt = 0; pt < 4; ++pt) { const size_t row = (size_t)(rowbase + (4 * phalf + pt) * 16 + i16);
#pragma unroll
                    for (int ct = 0; ct < 4; ++ct) { const int c = grp * 256 + (4 * cgrp + ct) * 16 + 4 * g16; u2[pt][ct] = *(const uint2*)(PROJ + row * NA + c); z2[pt][ct] = *(const uint2*)(PROJ + row * NA + 2 * E + c); } }
                __builtin_amdgcn_sched_barrier(0);
                f32x4 acc[4][4];
#pragma unroll
                for (int a = 0; a < 4; ++a)
#pragma unroll
                    for (int b = 0; b < 4; ++b) acc[a][b] = (f32x4){0.f, 0.f, 0.f, 0.f};
#pragma unroll
                for (int ks = 0; ks < 4; ++ks) {
                    bf16x8 bfr[4];
#pragma unroll
                    for (int pt = 0; pt < 4; ++pt) bfr[pt] = *(const LAS bf16x8*)(WN + (((4 * phalf + pt) * 4 + ks) * 64 + lc_) * 16);
#pragma unroll
                    for (int ct = 0; ct < 4; ++ct) {
                        const LAS unsigned char* base = VT + (32 * ks + 4 * g16 + (i16 >> 2)) * 544 + ((4 * cgrp + ct) * 16 + 4 * (i16 & 3)) * 2;
                        const s16x4 lo = tr16(base), hi = tr16(base + 16 * 544);
                        const bf16x8 afr = (bf16x8){lo[0], lo[1], lo[2], lo[3], hi[0], hi[1], hi[2], hi[3]};
#pragma unroll
                        for (int pt = 0; pt < 4; ++pt) acc[ct][pt] = __builtin_amdgcn_mfma_f32_16x16x32_bf16(afr, bfr[pt], acc[ct][pt], 0, 0, 0);
                    }
                }
                __syncthreads();
#pragma unroll
                for (int pt = 0; pt < 4; ++pt) {
                    const int p = (4 * phalf + pt) * 16 + i16; const size_t row = (size_t)(rowbase + p); const float bsv = args.in[7][grp * 128 + p];
#pragma unroll
                    for (int ct = 0; ct < 4; ++ct) {
                        const int c = grp * 256 + (4 * cgrp + ct) * 16 + 4 * g16;
                        const f32x4 vg = *(const f32x4*)(args.in[5] + c);
                        const f32x4 a = acc[ct][pt]; const uint2 uu = u2[pt][ct], zz = z2[pt][ct];
                        const float y0 = bflo(uu.x) * (a.x * vg.x + bsv) * bflo(zz.x), y1 = bfhi(uu.x) * (a.y * vg.y + bsv) * bfhi(zz.x);
                        const float y2 = bflo(uu.y) * (a.z * vg.z + bsv) * bflo(zz.y), y3 = bfhi(uu.y) * (a.w * vg.w + bsv) * bfhi(zz.y);
                        uint2 o; o.x = pg8::cvt_pk_bf16(y0, y1); o.y = pg8::cvt_pk_bf16(y2, y3);
                        *(uint2*)(Y + row * E + c) = o;
                    }
                }
            }
#undef A3_LOADV
            __syncthreads();
        }
#endif
        GRID_BAR();

        for (int repg_ = 0; repg_ < REP_A4; ++repg_) {
            PHASE_PTRS();
            pg8::Gemm g{Y, WAOUT, M, D, E}; pg8::StaticOrder S; S.init(M, D, G, bx);
            pg8::EpiResN Ep{xin, xo, (unsigned char*)XN, STATS1, args.in[2] + D};
            pg8::gemm_phase<pg8::EpiResN, pg8::StaticOrder, true, true, false, KREP_A4, XSYNC_ON>(lds, g, S, Ep, wave, lane, XSYNC_OF(1));
        }
        GRID_BAR();

        for (int repg_ = 0; repg_ < REP_B2; ++repg_) {
            PHASE_PTRS();
            pg8::Gemm g{XN, WBIN, M, NB, USE_F8 ? D / 2 : D}; pg8::StaticOrder S; S.init(M, NB, G, bx);
            pg8::EpiBin Ep{PROJ, STATS1, USE_F8 ? 0.03125f : 1.0f};
            pg8::gemm_phase<pg8::EpiBin, pg8::StaticOrder, true, true, USE_F8, KREP_B2, XSYNC_ON>(lds, g, S, Ep, wave, lane, XSYNC_OF(2));
        }
        GRID_BAR();

#ifndef SKIP_B3
        for (int rep_ = 0; rep_ < REP_B3; ++rep_) {
            PHASE_PTRS();
            const int g16 = lane >> 4, i16 = lane & 15;
            const int R = M / GRIDW;
            const int h = bx & 31, rsel = wave >> 2, qb = wave & 3;
            LAS unsigned char* RING = lds;
            LAS float* RPB = (LAS float*)(lds + 132096) + 64;
            for (int e = tid; e < 465 + 128; e += NWAVES * 64) { const int idx = e - 64; RPB[idx] = (idx >= 0 && idx < 465) ? args.in[10][(size_t)h * 465 + idx] * 1.4426950409f : 0.f; }
            __syncthreads();
            const int c = 16 * qb + i16, cs = min(max(c - 8, 0), GRIDW - 16), kc0 = min(max(16 * qb - 8, 0), 32), thr = cs - kc0;
            int coff[4]; unsigned msk[2] = {0u, 0u}; bool in0[4];
#pragma unroll
            for (int e = 0; e < 4; ++e) { in0[e] = (4 * g16 + e >= thr); coff[e] = kc0 + (in0[e] ? 0 : 16) + 4 * g16 + e - c + 15; if (in0[e]) msk[e >> 1] |= (e & 1) ? 0xffff0000u : 0x0000ffffu; }
            const bf16* Pq = PROJ + h * HD; const bf16* Pk = PROJ + E + h * HD; const bf16* Pv = PROJ + 2 * E + h * HD; const bf16* Pz = PROJ + 3 * E + h * HD;
            int offk[2], offv[2];
#pragma unroll
            for (int j = 0; j < 2; ++j) { const int lr = 4 * (8 * j + wave) + (lane >> 4), ch = lane & 15; offk[j] = lr * NB + ((ch ^ (lr & 15)) << 3); offv[j] = lr * NB + ((ch ^ ((lr & 7) << 1)) << 3); }
#define B3_GLDS(slot_, gb_, offs_) do { _Pragma("unroll") for (int j_ = 0; j_ < 2; ++j_) \
        __builtin_amdgcn_global_load_lds((const unsigned*)((gb_) + (offs_)[j_]), (LAS unsigned*)(RING + (slot_) * 16384 + (8 * j_ + wave) * 1024), 16, 0, 0); } while (0)
#define B3_ISSUE(pos_, rp_, ru_, slot_) do { \
        if ((pos_) < 2)       { const bf16* gb_ = Pq + (size_t)((2 * (rp_) + (pos_)) * GRIDW) * NB;        B3_GLDS(slot_, gb_, offk); } \
        else if ((pos_) < 11) { const bf16* gb_ = Pk + (size_t)(((ru_) + (pos_) - 2) * GRIDW) * NB;        B3_GLDS(slot_, gb_, offk); } \
        else if ((pos_) < 20) { const bf16* gb_ = Pv + (size_t)(((ru_) + (pos_) - 11) * GRIDW) * NB;       B3_GLDS(slot_, gb_, offv); } \
        else                  { const bf16* gb_ = Pz + (size_t)((2 * (rp_) + (pos_) - 20) * GRIDW) * NB;   B3_GLDS(slot_, gb_, offk); } } while (0)
#define B3_ISSUE2(pos_) do { if ((pos_) < 22) { B3_ISSUE((pos_), rp, ru, (sb + (pos_)) & 7); B3_ISSUE((pos_) + 1, rp, ru, (sb + (pos_) + 1) & 7); } \
        else { B3_ISSUE((pos_) - 22, rpn, run, (sb + (pos_)) & 7); B3_ISSUE((pos_) - 21, rpn, run, (sb + (pos_) + 1) & 7); } } while (0)
#define B3_WAITV(n_) asm volatile("s_waitcnt vmcnt(" #n_ ")" ::: "memory")
#define B3_BAR() do { asm volatile("s_waitcnt lgkmcnt(0)" ::: "memory"); __builtin_amdgcn_s_barrier(); asm volatile("" ::: "memory"); } while (0)
#define B3_POS(p_) { \
                    const LAS unsigned char* slot = RING + ((sb + (p_)) & 7) * 16384; \
                    if ((p_) == 1) { \
                        const LAS unsigned char* qs = RING + ((sb + rsel) & 7) * 16384; const int row = 16 * qb + i16; \
                        _Pragma("unroll") for (int ks = 0; ks < 4; ++ks) qf[ks] = *(const LAS bf16x8*)(qs + row * 256 + (((4 * ks + g16) ^ (row & 15)) << 4)); \
                    } \
                    if ((p_) >= 2 && (p_) < 11) { \
                        const int s = (p_) - 2; \
                        { bf16x8 kf[8]; \
                        _Pragma("unroll") for (int half = 0; half < 2; ++half) { const int row = kc0 + 16 * half + i16; \
                            _Pragma("unroll") for (int ks = 0; ks < 4; ++ks) kf[4 * half + ks] = *(const LAS bf16x8*)(slot + row * 256 + (((4 * ks + g16) ^ (row & 15)) << 4)); } \
                        __builtin_amdgcn_sched_barrier(0);                    \
                        _Pragma("unroll") for (int half = 0; half < 2; ++half) \
                            _Pragma("unroll") for (int ks = 0; ks < 4; ++ks) S[2 * s + half] = __builtin_amdgcn_mfma_f32_16x16x32_bf16(kf[4 * half + ks], qf[ks], S[2 * s + half], 0, 0, 0); } \
                    } \
                    if ((p_) == 10) { \
                        float mx = -__builtin_inff(); \
                        const LAS float* bp0 = RPB + (ru - r + 7) * 31 + coff[0]; const LAS float* bp1 = RPB + (ru - r + 7) * 31 + coff[1]; \
                        const LAS float* bp2 = RPB + (ru - r + 7) * 31 + coff[2]; const LAS float* bp3 = RPB + (ru - r + 7) * 31 + coff[3]; \
                        _Pragma("unroll") for (int s = 0; s < 9; ++s) { const bool rv = (ru + s >= rs) && (ru + s < rs + 8); \
                            float x0 = (in0[0] ? S[2 * s][0] : S[2 * s + 1][0]) + bp0[31 * s], x1 = (in0[1] ? S[2 * s][1] : S[2 * s + 1][1]) + bp1[31 * s]; \
                            float x2 = (in0[2] ? S[2 * s][2] : S[2 * s + 1][2]) + bp2[31 * s], x3 = (in0[3] ? S[2 * s][3] : S[2 * s + 1][3]) + bp3[31 * s]; \
                            if (!rv) { x0 = -__builtin_inff(); x1 = x0; x2 = x0; x3 = x0; } \
                            S[2 * s][0] = x0; S[2 * s][1] = x1; S[2 * s][2] = x2; S[2 * s][3] = x3; mx = fmaxf(fmaxf(mx, x0), fmaxf(fmaxf(x1, x2), x3)); } \
                        mx = fmaxf(mx, shx<16>(mx)); mx = max_x32(mx); \
                        _Pragma("unroll") for (int s = 0; s < 9; ++s) { \
                            const float p0 = __builtin_amdgcn_exp2f(S[2 * s][0] - mx), p1 = __builtin_amdgcn_exp2f(S[2 * s][1] - mx), p2 = __builtin_amdgcn_exp2f(S[2 * s][2] - mx), p3 = __builtin_amdgcn_exp2f(S[2 * s][3] - mx); \
                            l += (p0 + p1) + (p2 + p3); \
                            const unsigned w01 = pg8::cvt_pk_bf16(p0, p1), w23 = pg8::cvt_pk_bf16(p2, p3); \
                            const v4u pw = (v4u){w01 & msk[0], w23 & msk[1], w01 & ~msk[0], w23 & ~msk[1]}; P[s] = __builtin_bit_cast(bf16x8, pw); } \
                        l += shx<16>(l); l = add_x32(l); \
                    } \
                    if ((p_) >= 11 && (p_) < 20) { \
                        const int s = (p_) - 11; \
                        { \
                        const int row = kc0 + 4 * g16 + (i16 >> 2); \
                        const LAS unsigned char* vb = slot + row * 256 + (i16 & 3) * 8; \
                        s16x4 vlo[8], vhi[8]; \
                        _Pragma("unroll") for (int dt = 0; dt < 8; ++dt) { const int gofs = ((dt ^ (row & 7)) << 5); vlo[dt] = tr16(vb + gofs); vhi[dt] = tr16(vb + 16 * 256 + gofs); } \
                        __builtin_amdgcn_sched_barrier(0); \
                        _Pragma("unroll") for (int dt = 0; dt < 8; ++dt) { \
                            const bf16x8 afr = (bf16x8){vlo[dt][0], vlo[dt][1], vlo[dt][2], vlo[dt][3], vhi[dt][0], vhi[dt][1], vhi[dt][2], vhi[dt][3]}; \
                            O[dt] = __builtin_amdgcn_mfma_f32_16x16x32_bf16(afr, P[s], O[dt], 0, 0, 0); } } \
                    } \
                    if ((p_) == 21) { \
                        const LAS unsigned char* zs = RING + ((sb + 20 + rsel) & 7) * 16384; const int row = 16 * qb + i16; \
                        const float il = 32.0f / l;                           \
                        unsigned char* yptr = (unsigned char*)Y + (size_t)(r * GRIDW + c) * E + h * HD + 4 * g16; \
                        _Pragma("unroll") for (int dt = 0; dt < 8; ++dt) { \
                            const u32x2 z2 = *(const LAS u32x2*)(zs + row * 256 + (((2 * dt + (g16 >> 1)) ^ (row & 15)) << 4) + (g16 & 1) * 8); const f32x4 o = O[dt]; \
                            const float y0 = fminf(fmaxf(o.x * il * bflo(z2.x), -448.f), 448.f), y1 = fminf(fmaxf(o.y * il * bfhi(z2.x), -448.f), 448.f); \
                            const float y2 = fminf(fmaxf(o.z * il * bflo(z2.y), -448.f), 448.f), y3 = fminf(fmaxf(o.w * il * bfhi(z2.y), -448.f), 448.f); \
                            *(unsigned*)(yptr + 16 * dt) = pk4_fp8(y0, y1, y2, y3); } \
                    } \
                }
#define B3_PAIR(d_) { if ((d_) < 3 && k > 0) B3_WAITV(16); else B3_WAITV(8); B3_BAR(); B3_ISSUE2(2 * (d_) + 6); B3_POS(2 * (d_)) B3_POS(2 * (d_) + 1) }
            const int nu = (R / 2) / (G >> 5);
            {
                const int rp0 = bx >> 5, ru0 = min(min(max(2 * rp0 - 4, 0), R - 8), R - 9);
#pragma unroll
                for (int p = 0; p < 6; ++p) B3_ISSUE(p, rp0, ru0, p);
            }
            for (int k = 0; k < nu; ++k) {
                const int rp = (bx >> 5) + (G >> 5) * k, rpn = (k + 1 < nu) ? rp + (G >> 5) : rp;
                const int ru = min(min(max(2 * rp - 4, 0), R - 8), R - 9), run = min(min(max(2 * rpn - 4, 0), R - 8), R - 9);
                const int r = 2 * rp + rsel, rs = min(max(r - 4, 0), R - 8);
                const int sb = 6 * k;
                bf16x8 qf[4]; f32x4 S[18]; bf16x8 P[9]; f32x4 O[8]; float l = 0.f;
#pragma unroll
                for (int t = 0; t < 18; ++t) S[t] = (f32x4){0.f, 0.f, 0.f, 0.f};
#pragma unroll
                for (int dt = 0; dt < 8; ++dt) O[dt] = (f32x4){0.f, 0.f, 0.f, 0.f};
                B3_PAIR(0) B3_PAIR(1) B3_PAIR(2) B3_PAIR(3) B3_PAIR(4) B3_PAIR(5) B3_PAIR(6) B3_PAIR(7) B3_PAIR(8) B3_PAIR(9) B3_PAIR(10)
            }
            B3_WAITV(0); B3_BAR();
#undef B3_PAIR
#undef B3_POS
#undef B3_GLDS
#undef B3_ISSUE
#undef B3_ISSUE2
#undef B3_WAITV
#undef B3_BAR
        }
#endif
        GRID_BAR();

        {
            PHASE_PTRS();
            pg8::Gemm g{Y, WBOUT, M, D, E / 2}; pg8::StaticOrder S; S.init(M, D, G, bx);
            pg8::EpiRes Ep{xo, xo, 1.0f / 1024.0f};
            pg8::gemm_phase<pg8::EpiRes, pg8::StaticOrder, true, true, true, 1, XSYNC_ON>(lds, g, S, Ep, wave, lane, XSYNC_OF(3));
        }
        GRID_BAR();

        { PHASE_PTRS(); for (int row = gw; row < M; row += NGW) rms_row_inplace(xo + (size_t)row * D, args.in[3], lane); }
    }
}

extern "C" void kernel_launch(void* const* d_in, const int* in_sizes, int n_in, void* d_out, int out_size, void* d_ws, size_t ws_size, hipStream_t stream) {
    static int grid = 0;
    if (grid == 0) {
        if (n_in != 12 || out_size != NTOK * D || ws_size < WS_END) { fprintf(stderr, "kernel_launch: unexpected shapes: n_in %d out %d ws %zu (need %zu)\n", n_in, out_size, ws_size, (size_t)WS_END); grid = -1; return; }
        int dev = 0, cus = 0, per_cu = 0;
        if (hipGetDevice(&dev) != hipSuccess || hipDeviceGetAttribute(&cus, hipDeviceAttributeMultiprocessorCount, dev) != hipSuccess) { grid = -1; return; }
        if (hipFuncSetAttribute((const void*)fwd, hipFuncAttributeMaxDynamicSharedMemorySize, LDS_BYTES) != hipSuccess) { fprintf(stderr, "kernel_launch: hipFuncSetAttribute failed\n"); grid = -1; return; }
        if (hipOccupancyMaxActiveBlocksPerMultiprocessor(&per_cu, (const void*)fwd, NWAVES * 64, LDS_BYTES) != hipSuccess || per_cu < 1)
            fprintf(stderr, "kernel_launch: note: occupancy query reports %d workgroups per CU\n", per_cu);
        (void)hipGetLastError();
        grid = cus;
    }
    if (grid < 0) return;
    if (hipMemsetAsync((char*)d_ws + WS_CTL, 0, CTL_ZERO_BYTES, stream) != hipSuccess) { fprintf(stderr, "kernel_launch: hipMemsetAsync failed\n"); return; }
    Args a{};
    for (int i = 0; i < 12; ++i) a.in[i] = (const float*)d_in[i];
    a.out = (float*)d_out; a.ws = (unsigned char*)d_ws;
    hipLaunchKernelGGL(fwd, dim3(grid), dim3(NWAVES * 64), LDS_BYTES, stream, a);
    const hipError_t le = hipPeekAtLastError();
    if (le != hipSuccess) fprintf(stderr, "kernel_launch: launch failed: %s\n", hipGetErrorName(le));
}
```
